# Optimizing an MI355X kernel written in HIP

```python
import math
import jax, jax.numpy as jnp
from jax import lax
import numpy as np

D_MODEL = 1024
BATCH = 4
SEQ = 8192
DEPTH = 2

CTX_LEN = 256
GRID_W = 64
N_MOD = 9
ATTN_WIDTH = 512
CONV_WIDTH = 256
FOURIER_WIDTH = 256
MIX_WIDTH = ATTN_WIDTH + CONV_WIDTH + FOURIER_WIDTH
N_HEADS = 4
HEAD_DIM = 64
V_DIM = 2 * HEAD_DIM
QK_WIDTH = N_HEADS * 2 * HEAD_DIM
V_WIDTH = N_HEADS * V_DIM
ATTN_IN = 2 * QK_WIDTH + V_WIDTH
CONV_IN = 2 * CONV_WIDTH
IN_WIDTH = ATTN_IN + CONV_IN + FOURIER_WIDTH
CONV_K = 31
FOURIER_GROUPS = 4
FOURIER_GDIM = FOURIER_WIDTH // FOURIER_GROUPS
D_FF = 2816
ROPE_BASE = 10000.0
ROT_AXIS = HEAD_DIM // 2
Q_BLOCK = 128
EPS = 1e-6

kernel_name = "hybrid_diffattn_conformer_fnet_macaron_dit"


def rmsnorm(x, g):
    xf = x.astype(jnp.float32)
    y = xf * lax.rsqrt(jnp.mean(xf * xf, axis=-1, keepdims=True) + EPS)
    return (y * g.astype(jnp.float32)).astype(x.dtype)


def modulate(h, shift, scale):
    return h * (1 + scale) + shift


def swiglu(h, wg, wu, wd):
    return (jax.nn.silu(h @ wg) * (h @ wu)) @ wd


def axial_rope_tables(n):
    rows = n // GRID_W
    row = jnp.broadcast_to(jnp.arange(rows)[:, None], (rows, GRID_W)).reshape(-1)
    col = jnp.broadcast_to(jnp.arange(GRID_W)[None, :], (rows, GRID_W)).reshape(-1)
    inv = ROPE_BASE ** (-jnp.arange(0, ROT_AXIS, 2, dtype=jnp.float32) / ROT_AXIS)
    ang_r = row.astype(jnp.float32)[:, None] * inv
    ang_c = col.astype(jnp.float32)[:, None] * inv
    shp = (n, 1, 1, ROT_AXIS // 2)
    return (jnp.cos(ang_r).reshape(shp), jnp.sin(ang_r).reshape(shp),
            jnp.cos(ang_c).reshape(shp), jnp.sin(ang_c).reshape(shp))


def rotate(x, cos, sin):
    x1, x2 = jnp.split(x, 2, axis=-1)
    return jnp.concatenate([x1 * cos - x2 * sin, x2 * cos + x1 * sin], axis=-1)


def apply_axial_rope(x, rope):
    cos_r, sin_r, cos_c, sin_c = rope
    xf = x.astype(jnp.float32)
    out = jnp.concatenate([rotate(xf[..., :ROT_AXIS], cos_r, sin_r),
                           rotate(xf[..., ROT_AXIS:], cos_c, sin_c)], axis=-1)
    return out.astype(x.dtype)


def split_qkv(u):
    b, n = u.shape[0], u.shape[1]
    q = u[..., :QK_WIDTH].reshape(b, n, N_HEADS, 2, HEAD_DIM)
    k = u[..., QK_WIDTH:2 * QK_WIDTH].reshape(b, n, N_HEADS, 2, HEAD_DIM)
    v = u[..., 2 * QK_WIDTH:].reshape(b, n, N_HEADS, V_DIM)
    return q, k, v


def diff_scores_to_out(qb, k, v, lam):
    s = jnp.einsum('bhiqd,bhikd->bhiqk', qb, k, preferred_element_type=jnp.float32) * (HEAD_DIM ** -0.5)
    p = jax.nn.softmax(s, axis=-1)
    p_diff = p[:, :, 0] - lam * p[:, :, 1]
    return jnp.einsum('bhqk,bhkd->bhqd', p_diff.astype(v.dtype), v)


def diff_head_norm(o, g_subln, lam_init):
    o = rmsnorm(o, g_subln) * (1.0 - lam_init)
    return o.reshape(o.shape[0], o.shape[1], V_WIDTH)


def diff_attention(u_lat, u_ctx, lam, lam_init, g_subln, rope, need_ctx_out):
    b, n = u_lat.shape[0], u_lat.shape[1]
    q_l, k_l, v_l = split_qkv(u_lat)
    q_c, k_c, v_c = split_qkv(u_ctx)
    q_l = apply_axial_rope(q_l, rope)
    k_l = apply_axial_rope(k_l, rope)
    q_l = q_l.transpose(0, 2, 3, 1, 4)
    k_l = k_l.transpose(0, 2, 3, 1, 4)
    q_c = q_c.transpose(0, 2, 3, 1, 4)
    k_c = k_c.transpose(0, 2, 3, 1, 4)
    v_l = v_l.transpose(0, 2, 1, 3)
    v_c = v_c.transpose(0, 2, 1, 3)
    k_all = jnp.concatenate([k_l, k_c], axis=3)
    v_all = jnp.concatenate([v_l, v_c], axis=2)
    nb = n // Q_BLOCK
    q_blocks = jnp.moveaxis(q_l.reshape(b, N_HEADS, 2, nb, Q_BLOCK, HEAD_DIM), 3, 0)
    o = lax.map(lambda qb: diff_scores_to_out(qb, k_all, v_all, lam), q_blocks)
    o = o.transpose(1, 0, 3, 2, 4).reshape(b, n, N_HEADS, V_DIM)
    o_lat = diff_head_norm(o, g_subln, lam_init)
    o_ctx = None
    if need_ctx_out:
        oc = diff_scores_to_out(q_c, k_c, v_c, lam).transpose(0, 2, 1, 3)
        o_ctx = diff_head_norm(oc, g_subln, lam_init)
    return o_lat, o_ctx


def conformer_conv(u, w_dw, b_dw, g_ln, b_ln, w_pw, b_pw):
    a, gate = jnp.split(u, 2, axis=-1)
    y = a * jax.nn.sigmoid(gate)
    y = lax.conv_general_dilated(y, w_dw[:, None, :], window_strides=(1,),
                                 padding=[(CONV_K // 2, CONV_K // 2)],
                                 dimension_numbers=('NWC', 'WIO', 'NWC'),
                                 feature_group_count=CONV_WIDTH) + b_dw
    yf = y.astype(jnp.float32)
    mu = jnp.mean(yf, axis=-1, keepdims=True)
    var = jnp.mean(jnp.square(yf - mu), axis=-1, keepdims=True)
    yf = (yf - mu) * lax.rsqrt(var + EPS) * g_ln.astype(jnp.float32) + b_ln.astype(jnp.float32)
    y = jax.nn.silu(yf).astype(u.dtype)
    return y @ w_pw + b_pw


def fourier_mix(u, w_f, b_f):
    b, n = u.shape[0], u.shape[1]
    uf = u.astype(jnp.float32).reshape(b, n, FOURIER_GROUPS, FOURIER_GDIM)
    f = jnp.fft.fft2(uf, axes=(1, 3), norm='ortho').real
    f = f.reshape(b, n, FOURIER_WIDTH).astype(u.dtype)
    return f @ w_f + b_f


def ffn_sublayer(s, m, i, g, wg, wu, wd):
    h = modulate(rmsnorm(s, g), m[3 * i], m[3 * i + 1])
    return s + 0.5 * m[3 * i + 2] * swiglu(h, wg, wu, wd)


def hybrid_layer(x, ctx, mod_x, mod_c, p, lam_init, rope, need_ctx_out):
    mx = jnp.split(mod_x, N_MOD, axis=-1)
    mc = jnp.split(mod_c, N_MOD, axis=-1)
    x = ffn_sublayer(x, mx, 0, p['g_ffn1'], p['w1g'], p['w1u'], p['w1d'])
    ctx = ffn_sublayer(ctx, mc, 0, p['g_ffn1'], p['w1g'], p['w1u'], p['w1d'])
    h = modulate(rmsnorm(x, p['g_mix']), mx[3], mx[4])
    hc = modulate(rmsnorm(ctx, p['g_mix']), mc[3], mc[4])
    u = h @ p['w_in']
    uc = hc @ p['w_in']
    lam = (jnp.exp(jnp.sum(p['lq1'].astype(jnp.float32) * p['lk1'].astype(jnp.float32)))
           - jnp.exp(jnp.sum(p['lq2'].astype(jnp.float32) * p['lk2'].astype(jnp.float32)))
           + lam_init)
    a_lat, a_ctx = diff_attention(u[..., :ATTN_IN], uc[..., :ATTN_IN], lam, lam_init,
                                  p['g_subln'], rope, need_ctx_out)
    conv_args = (p['w_dw'], p['b_dw'], p['g_cln'], p['b_cln'], p['w_pw'], p['b_pw'])
    conv_lat = conformer_conv(u[..., ATTN_IN:ATTN_IN + CONV_IN], *conv_args)
    four_lat = fourier_mix(u[..., ATTN_IN + CONV_IN:], p['w_f'], p['b_f'])
    y = jnp.concatenate([a_lat, conv_lat, four_lat], axis=-1) @ p['w_out']
    x = x + mx[5] * y
    if need_ctx_out:
        conv_ctx = conformer_conv(uc[..., ATTN_IN:ATTN_IN + CONV_IN], *conv_args)
        four_ctx = fourier_mix(uc[..., ATTN_IN + CONV_IN:], p['w_f'], p['b_f'])
        yc = jnp.concatenate([a_ctx, conv_ctx, four_ctx], axis=-1) @ p['w_out']
        ctx = ctx + mc[5] * yc
        ctx = ffn_sublayer(ctx, mc, 2, p['g_ffn2'], p['w2g'], p['w2u'], p['w2d'])
    x = ffn_sublayer(x, mx, 2, p['g_ffn2'], p['w2g'], p['w2u'], p['w2d'])
    return x, ctx


def setup_inputs(seed: int = 0) -> dict:
    key = jax.random.key(seed)
    ks = jax.random.split(key, 40)
    f32 = jnp.float32

    def nrm(k, shape, scale):
        return jax.random.normal(k, shape, f32) * scale

    def gain(k, shape):
        return 1.0 + 0.02 * jax.random.normal(k, shape, f32)

    L = DEPTH
    return {
        "x": nrm(ks[0], (BATCH, SEQ, D_MODEL), 1.0),
        "c": nrm(ks[1], (BATCH, D_MODEL), 1.0),
        "ctx": nrm(ks[2], (BATCH, CTX_LEN, D_MODEL), 1.0),
        "c_ctx": nrm(ks[3], (D_MODEL,), 1.0),
        "w_ada": nrm(ks[4], (L, D_MODEL, N_MOD * D_MODEL), 0.5 * D_MODEL ** -0.5),
        "b_ada": nrm(ks[5], (L, N_MOD * D_MODEL), 0.01),
        "g_ffn1": gain(ks[6], (L, D_MODEL)),
        "g_mix": gain(ks[7], (L, D_MODEL)),
        "g_ffn2": gain(ks[8], (L, D_MODEL)),
        "w_ffn1_gate": nrm(ks[9], (L, D_MODEL, D_FF), D_MODEL ** -0.5),
        "w_ffn1_up": nrm(ks[10], (L, D_MODEL, D_FF), D_MODEL ** -0.5),
        "w_ffn1_down": nrm(ks[11], (L, D_FF, D_MODEL), D_FF ** -0.5),
        "w_ffn2_gate": nrm(ks[12], (L, D_MODEL, D_FF), D_MODEL ** -0.5),
        "w_ffn2_up": nrm(ks[13], (L, D_MODEL, D_FF), D_MODEL ** -0.5),
        "w_ffn2_down": nrm(ks[14], (L, D_FF, D_MODEL), D_FF ** -0.5),
        "w_in": nrm(ks[15], (L, D_MODEL, IN_WIDTH), D_MODEL ** -0.5),
        "lambda_q1": nrm(ks[16], (L, HEAD_DIM), 0.1),
        "lambda_k1": nrm(ks[17], (L, HEAD_DIM), 0.1),
        "lambda_q2": nrm(ks[18], (L, HEAD_DIM), 0.1),
        "lambda_k2": nrm(ks[19], (L, HEAD_DIM), 0.1),
        "g_subln": gain(ks[20], (L, V_DIM)),
        "w_dw": nrm(ks[21], (L, CONV_K, CONV_WIDTH), CONV_K ** -0.5),
        "b_dw": nrm(ks[22], (L, CONV_WIDTH), 0.01),
        "g_conv_ln": gain(ks[23], (L, CONV_WIDTH)),
        "b_conv_ln": nrm(ks[24], (L, CONV_WIDTH), 0.01),
        "w_pw": nrm(ks[25], (L, CONV_WIDTH, CONV_WIDTH), CONV_WIDTH ** -0.5),
        "b_pw": nrm(ks[26], (L, CONV_WIDTH), 0.01),
        "w_fourier": nrm(ks[27], (L, FOURIER_WIDTH, FOURIER_WIDTH), FOURIER_WIDTH ** -0.5),
        "b_fourier": nrm(ks[28], (L, FOURIER_WIDTH), 0.01),
        "w_out": nrm(ks[29], (L, MIX_WIDTH, D_MODEL), MIX_WIDTH ** -0.5),
        "g_final": gain(ks[30], (D_MODEL,)),
    }


def reference(x, c, ctx, c_ctx, w_ada, b_ada, g_ffn1, g_mix, g_ffn2,
              w_ffn1_gate, w_ffn1_up, w_ffn1_down, w_ffn2_gate, w_ffn2_up, w_ffn2_down,
              w_in, lambda_q1, lambda_k1, lambda_q2, lambda_k2, g_subln,
              w_dw, b_dw, g_conv_ln, b_conv_ln, w_pw, b_pw, w_fourier, b_fourier,
              w_out, g_final):
    n = x.shape[1]
    rope = axial_rope_tables(n)
    for l in range(DEPTH):
        lam_init = 0.8 - 0.6 * math.exp(-0.3 * l)
        mod_x = (jax.nn.silu(c) @ w_ada[l] + b_ada[l])[:, None, :]
        mod_c = (jax.nn.silu(c_ctx) @ w_ada[l] + b_ada[l])[None, None, :]
        p = dict(g_ffn1=g_ffn1[l], g_mix=g_mix[l], g_ffn2=g_ffn2[l],
                 w1g=w_ffn1_gate[l], w1u=w_ffn1_up[l], w1d=w_ffn1_down[l],
                 w2g=w_ffn2_gate[l], w2u=w_ffn2_up[l], w2d=w_ffn2_down[l],
                 w_in=w_in[l], lq1=lambda_q1[l], lk1=lambda_k1[l],
                 lq2=lambda_q2[l], lk2=lambda_k2[l], g_subln=g_subln[l],
                 w_dw=w_dw[l], b_dw=b_dw[l], g_cln=g_conv_ln[l], b_cln=b_conv_ln[l],
                 w_pw=w_pw[l], b_pw=b_pw[l], w_f=w_fourier[l], b_f=b_fourier[l],
                 w_out=w_out[l])
        x, ctx = hybrid_layer(x, ctx, mod_x, mod_c, p, lam_init, rope,
                              need_ctx_out=(l < DEPTH - 1))
    return rmsnorm(x, g_final)
```

```cpp
#include <hip/hip_runtime.h>
#include <hip/hip_cooperative_groups.h>
#include <cstdio>
#include <cstdint>
namespace cg = cooperative_groups;

#ifndef LEVEL
#define LEVEL 9
#endif

#define LAS __attribute__((address_space(3)))
typedef unsigned short bf16_t;
typedef short bf16x8 __attribute__((ext_vector_type(8)));
typedef float f32x4 __attribute__((ext_vector_type(4)));
typedef float f32x2 __attribute__((ext_vector_type(2)));
typedef float f32x16 __attribute__((ext_vector_type(16)));
typedef unsigned u32x4 __attribute__((ext_vector_type(4)));
typedef unsigned u32x2 __attribute__((ext_vector_type(2)));
typedef __bf16 bf16x2_t __attribute__((ext_vector_type(2)));

constexpr int DM = 1024, NB = 4, SEQ = 8192, CTXL = 256, NLAT = NB * SEQ, NCTX = NB * CTXL, MROWS = NLAT + NCTX;
constexpr int DFF = 2816, NKV = SEQ + CTXL, NMOD = 9 * DM;
constexpr float EPS = 1e-6f;
constexpr float LOG2E = 1.4426950408889634f;
constexpr float QSCALE = 0.125f * LOG2E;

constexpr size_t WS_BAR = 0;
constexpr size_t WS_MOD = 16384;
constexpr size_t WS_BIASY = WS_MOD + 2 * 5 * NMOD * 4;
constexpr size_t WS_ROPE = WS_BIASY + 2 * 1024 * 4;
constexpr size_t WS_DA = WS_ROPE + 129 * 16 * 8 + 128;
constexpr size_t WS_E256 = WS_DA + 256 * 256 * 2;
constexpr size_t WS_EBD = WS_E256 + 256 * 512 * 2;
constexpr size_t WS_XC = WS_EBD + (size_t)8192 * 512 * 2;
constexpr size_t WS_W = WS_XC + (size_t)NCTX * DM * 4;
constexpr size_t W_FF1A = 0, W_DN1 = W_FF1A + (size_t)5632 * 1024 * 2, W_FF2A = W_DN1 + (size_t)1024 * 2816 * 2,
                 W_DN2 = W_FF2A + (size_t)5632 * 1024 * 2, W_INM = W_DN2 + (size_t)1024 * 2816 * 2, W_WV = W_INM + (size_t)1536 * 1024 * 2,
                 W_WFR = W_WV + (size_t)512 * 1024 * 2, W_WOUT = W_WFR + (size_t)512 * 1024 * 2, WL = W_WOUT + (size_t)1024 * 1024 * 2;
constexpr size_t WS_HBF = WS_W + 2 * WL;
constexpr size_t WS_REG = WS_HBF + (size_t)MROWS * DM * 2;
constexpr size_t R_ACT = 0;
constexpr size_t R_QS = 0, R_KS = R_QS + (size_t)32 * NKV * 64 * 2, R_VT = R_KS + (size_t)32 * NKV * 64 * 2,
                 R_YGLU = R_VT + (size_t)16 * 128 * NKV * 2, R_GT = R_YGLU + (size_t)MROWS * 256 * 2, R_HBFP = R_GT + (size_t)65536 * 256 * 2,
                 R_T = R_HBFP, R_GTC = R_HBFP + (size_t)NLAT * DM * 2, R_CAT = R_GTC + (size_t)1024 * 512 * 2, R_END = R_CAT + (size_t)MROWS * DM * 2;
constexpr size_t WS_PART = WS_REG + (R_END > (size_t)MROWS * DFF * 2 ? R_END : (size_t)MROWS * DFF * 2);
constexpr size_t WS_END = WS_PART + (size_t)11 * NCTX * DM * 4;
static_assert(WS_W % 256 == 0 && WS_HBF % 256 == 0 && WS_REG % 256 == 0 && WS_EBD % 256 == 0 && WS_DA % 256 == 0, "align");

constexpr int LDS_BYTES = 147456, PD_OFF = 131072 + 1024, PP_OFF = PD_OFF + 512, XB_OFF = PP_OFF + 512;

__device__ __forceinline__ unsigned cvtpk(float lo, float hi) { f32x2 v = {lo, hi}; bf16x2_t b = __builtin_convertvector(v, bf16x2_t); return __builtin_bit_cast(unsigned, b); }
__device__ __forceinline__ float bf2f(unsigned v16) { return __uint_as_float(v16 << 16); }
__device__ __forceinline__ float shx(float v, int o, int lane) { return __int_as_float(__builtin_amdgcn_ds_bpermute((lane ^ o) << 2, __float_as_int(v))); }
__device__ __forceinline__ float wave_sum(float v, int lane) {
#pragma unroll
  for (int o = 1; o < 64; o <<= 1) v += shx(v, o, lane);
  return v;
}
__device__ __forceinline__ float sigmoid_f(float x) { return __builtin_amdgcn_rcpf(1.f + __builtin_amdgcn_exp2f(-LOG2E * x)); }
__device__ __forceinline__ float silu_f(float x) { return x * sigmoid_f(x); }
__device__ __forceinline__ u32x4 pack8(const f32x4 a, const f32x4 b) { u32x4 w; w.x = cvtpk(a[0], a[1]); w.y = cvtpk(a[2], a[3]); w.z = cvtpk(b[0], b[1]); w.w = cvtpk(b[2], b[3]); return w; }

namespace pg8 {
constexpr int BM = 256, BK = 64, HALF = 128, HTB = HALF * BK * 2, STAGE_BYTES = 8 * HTB;
__device__ __forceinline__ int lds_byte(int r, int c) { const int st = (r >> 4) * 2 + (c >> 5), rr = r & 15, cc = c & 31, ob = rr * 64 + cc * 2; return st * 1024 + (ob ^ (((ob >> 9) & 1) << 5)); }
__device__ __forceinline__ void stage_rc(int b, int& R, int& C) { const int st = b / 1024, sb = b % 1024, swz = sb ^ (((sb >> 9) & 1) << 5); R = (st >> 1) * 16 + swz / 64; C = (st & 1) * 32 + (swz % 64) / 2; }
__device__ __forceinline__ int perm32(int rho) { const int n = rho >> 4, i = rho & 15; return 8 * (i >> 2) + 4 * n + (i & 3); }

struct Unit { const char* A; const char* B; int pm, pn, kind, nt, kc; };
struct Job { const char* A; const char* B; int nM, nN, kind, kshift, nt, ksplit, pmoff, pad_; };
struct PhaseDesc {
  Job j[4]; int e[4];
  const float* xin_lat; const float* xin_ctx; float* xout_lat; float* xout_ctx; const float* mod; const float* biasy; int gate_idx; float gate_mul;
};
__device__ __forceinline__ int rfl(int v) { return __builtin_amdgcn_readfirstlane(v); }
__device__ __forceinline__ const char* rflp(const char* p) { const unsigned long long u = (unsigned long long)p; const unsigned lo = (unsigned)rfl((int)(unsigned)u), hi = (unsigned)rfl((int)(unsigned)(u >> 32)); return (const char*)(((unsigned long long)hi << 32) | lo); }
struct Sched {
  const LAS PhaseDesc* pd; int G, c; size_t tsA, tsB;
  __device__ __forceinline__ bool next(int i, Unit& u) const {
    const long L = (long)i * G + c; const int e0 = rfl(pd->e[0]), e1 = rfl(pd->e[1]), e2 = rfl(pd->e[2]), e3 = rfl(pd->e[3]);
    if (L >= e3) return false;
    int ji, Ll;
    if (L < e0) { ji = 0; Ll = (int)L; } else if (L < e1) { ji = 1; Ll = (int)L - e0; } else if (L < e2) { ji = 2; Ll = (int)L - e1; } else { ji = 3; Ll = (int)L - e2; }
    const LAS Job* J = &pd->j[ji];
    const int nM = rfl(J->nM), nN = rfl(J->nN), kshift = rfl(J->kshift), ksplit = rfl(J->ksplit), jnt = rfl(J->nt);
    const int nwg = nM * nN * ksplit, q = nwg / 8, r = nwg % 8, xcd = Ll % 8, off = Ll / 8;
    const int w0 = (xcd < r ? xcd * (q + 1) : r * (q + 1) + (xcd - r) * q) + off;
    const int kc = w0 % ksplit, w = w0 / ksplit;
    const int nig = 8 * nN, gid = w / nig, fm = gid * 8, gsz = (nM - fm) < 8 ? (nM - fm) : 8;
    const int pm = fm + ((w % nig) % gsz);
    u.pm = pm + rfl(J->pmoff); u.pn = (w % nig) / gsz; u.kind = rfl(J->kind); u.nt = jnt; u.kc = kc;
    u.A = rflp(J->A) + (size_t)pm * tsA + (size_t)kc * jnt * 128; u.B = rflp(J->B) + (size_t)u.pn * tsB + (size_t)pm * (size_t)kshift + (size_t)kc * jnt * 128;
    return true;
  }
};

template <class Epi>
__device__ __forceinline__ void gemm_phase(LAS unsigned char* lds, const int tid, const int lda, const int ldb, const Sched& S, const Epi& E) {
  const int wid = __builtin_amdgcn_readfirstlane(tid >> 6), lane = tid & 63, wr = wid >> 2, wc = wid & 3, fr = lane & 15, fq = lane >> 4;
  unsigned voffA[2], voffB[2];
#pragma unroll
  for (int i = 0; i < 2; ++i) { int R, C; stage_rc(tid * 16 + i * 8192, R, C); const int Rb = (R & ~31) + perm32(R & 31);
    voffA[i] = (unsigned)(R * lda + C) * 2u; voffB[i] = (unsigned)(Rb * ldb + C) * 2u; }
  const size_t kstep = (size_t)(BK * 2);
  const size_t hstepA = (size_t)HALF * lda * 2, hstepB = (size_t)HALF * ldb * 2;
  const unsigned ldsw = (unsigned)wid * 1024u;
  const int aoff = lds_byte(wr * 64 + fr, fq * 8), boff = lds_byte(wc * 32 + fr, fq * 8);
#define PG8_SA(b, h) (((b) * 2 + (h)) * HTB)
#define PG8_SB(b, h) ((4 + (b) * 2 + (h)) * HTB)
#define PG8_STAGE(bufoff, gbase, voff) do { _Pragma("unroll") for (int _i = 0; _i < 2; ++_i) \
    __builtin_amdgcn_global_load_lds((const unsigned*)((const char*)(gbase) + (voff)[_i]), (LAS unsigned*)(lds + (bufoff) + ldsw + _i * 8192), 16, 0, 0); } while (0)
#define PG8_LDA(dst, b, h) do { _Pragma("unroll") for (int m = 0; m < 4; ++m) _Pragma("unroll") for (int k = 0; k < 2; ++k) dst[m][k] = *(const LAS bf16x8*)(lds + PG8_SA(b, h) + aoff + m * 2048 + k * 1024); } while (0)
#define PG8_LDB(dst, b, h) do { _Pragma("unroll") for (int n = 0; n < 2; ++n) _Pragma("unroll") for (int k = 0; k < 2; ++k) dst[n][k] = *(const LAS bf16x8*)(lds + PG8_SB(b, h) + boff + n * 2048 + k * 1024); } while (0)
#define PG8_MMA(ai, bj, At, Bt) do { __builtin_amdgcn_s_setprio(1); _Pragma("unroll") for (int m = 0; m < 4; ++m) _Pragma("unroll") for (int n = 0; n < 2; ++n) _Pragma("unroll") for (int k = 0; k < 2; ++k) \
    acc[ai][bj][m][n] = __builtin_amdgcn_mfma_f32_16x16x32_bf16(Bt[n][k], At[m][k], acc[ai][bj][m][n], 0, 0, 0); __builtin_amdgcn_s_setprio(0); } while (0)
#define PG8_WAIT_V(n) asm volatile("s_waitcnt vmcnt(" #n ")" ::: "memory")
#define PG8_WAIT_L(n) asm volatile("s_waitcnt lgkmcnt(" #n ")" ::: "memory")
#define PG8_BAR __builtin_amdgcn_s_barrier()
#define PG8_SCHED __builtin_amdgcn_sched_barrier(0)
  Unit cur, nxt; int ui = 0;
  if (!S.next(0, cur)) return;
  f32x4 acc[2][2][4][2];
#pragma unroll
  for (int a = 0; a < 2; ++a)
#pragma unroll
    for (int b = 0; b < 2; ++b)
#pragma unroll
      for (int m = 0; m < 4; ++m)
#pragma unroll
        for (int n = 0; n < 2; ++n) acc[a][b][m][n] = (f32x4){0.f, 0.f, 0.f, 0.f};
  bf16x8 At[4][2], B0[2][2], B1[2][2];
  const char* cA = cur.A; const char* cB = cur.B;
  PG8_STAGE(PG8_SB(0, 0), cB, voffB); PG8_STAGE(PG8_SB(0, 1), cB + hstepB, voffB); PG8_STAGE(PG8_SA(0, 0), cA, voffA); PG8_STAGE(PG8_SA(0, 1), cA + hstepA, voffA);
  if (wr == 1) PG8_BAR;
  PG8_WAIT_V(2); PG8_BAR;
  PG8_STAGE(PG8_SB(1, 0), cB + kstep, voffB); PG8_STAGE(PG8_SA(1, 0), cA + kstep, voffA); PG8_STAGE(PG8_SB(1, 1), cB + hstepB + kstep, voffB);
  PG8_WAIT_V(6); PG8_BAR;
  for (;;) {
    const bool has_next = S.next(ui + 1, nxt);
    const char* nA = has_next ? nxt.A : cA; const char* nB = has_next ? nxt.B : cB;
    const int nt = cur.nt;
    for (int t = 0; t < nt; t += 2) {
      const bool last = (t == nt - 2);
      const char* a1 = cA + (size_t)(t + 1) * kstep;
      const char* a2 = last ? nA : cA + (size_t)(t + 2) * kstep; const char* b2 = last ? nB : cB + (size_t)(t + 2) * kstep;
      const char* a3 = a2 + kstep; const char* b3 = b2 + kstep;
      PG8_LDB(B0, 0, 0); PG8_LDB(B1, 0, 1); PG8_SCHED; PG8_LDA(At, 0, 0); PG8_STAGE(PG8_SA(1, 1), a1 + hstepA, voffA);
      PG8_WAIT_V(8); PG8_WAIT_L(0); PG8_BAR; PG8_MMA(0, 0, At, B0); PG8_MMA(0, 1, At, B1); PG8_BAR; PG8_SCHED;
      PG8_LDA(At, 0, 1); PG8_STAGE(PG8_SB(0, 0), b2, voffB); PG8_STAGE(PG8_SB(0, 1), b2 + hstepB, voffB); PG8_STAGE(PG8_SA(0, 0), a2, voffA);
      PG8_WAIT_V(8); PG8_WAIT_L(0); PG8_BAR; PG8_MMA(1, 0, At, B0); PG8_MMA(1, 1, At, B1); PG8_BAR; PG8_SCHED;
      PG8_LDB(B0, 1, 0); PG8_LDB(B1, 1, 1); PG8_SCHED; PG8_LDA(At, 1, 0); PG8_STAGE(PG8_SA(0, 1), a2 + hstepA, voffA);
      PG8_WAIT_V(8); PG8_WAIT_L(0); PG8_BAR; PG8_MMA(0, 0, At, B0); PG8_MMA(0, 1, At, B1); PG8_BAR; PG8_SCHED;
      PG8_LDA(At, 1, 1); PG8_STAGE(PG8_SB(1, 0), b3, voffB); PG8_STAGE(PG8_SB(1, 1), b3 + hstepB, voffB); PG8_STAGE(PG8_SA(1, 0), a3, voffA);
      PG8_WAIT_V(8); PG8_WAIT_L(0); PG8_BAR; PG8_MMA(1, 0, At, B0); PG8_MMA(1, 1, At, B1); PG8_BAR; PG8_SCHED;
    }
    if (wr == 0) PG8_BAR;
    { int fr_ = fr, fq_ = fq, wr_ = wr, wc_ = wc; asm volatile("" : "+v"(fr_), "+v"(fq_), "+s"(wr_), "+s"(wc_));
      E(acc, cur, wr_, wc_, fr_, fq_); }
    if (!has_next) break;
#pragma unroll
    for (int a = 0; a < 2; ++a)
#pragma unroll
      for (int b = 0; b < 2; ++b)
#pragma unroll
        for (int m = 0; m < 4; ++m)
#pragma unroll
          for (int n = 0; n < 2; ++n) acc[a][b][m][n] = (f32x4){0.f, 0.f, 0.f, 0.f};
    cur = nxt; cA = nA; cB = nB; ++ui;
    if (wr == 1) PG8_BAR;
  }
  PG8_WAIT_V(0);
  PG8_BAR;
#undef PG8_SA
#undef PG8_SB
#undef PG8_STAGE
#undef PG8_LDA
#undef PG8_LDB
#undef PG8_MMA
#undef PG8_WAIT_V
#undef PG8_WAIT_L
#undef PG8_BAR
#undef PG8_SCHED
}
}

enum Kind { K_GATEUP = 0, K_RES = 1, K_INM = 2, K_VT = 3, K_FG = 4, K_FGC = 5, K_STA = 6, K_STB = 7, K_FC = 8, K_RESP = 9 };

struct Epi {
  unsigned char* ws;
  const LAS pg8::PhaseDesc* pd;
  __device__ __forceinline__ void operator()(f32x4 (&acc)[2][2][4][2], const pg8::Unit& u, int wr, int wc, int fr, int fq) const {
    const int kind = u.kind, pm = u.pm, pn = u.pn;
    const unsigned rlane = (unsigned)(wr * 64 + fr);
    const unsigned clane = (unsigned)(wc * 32 + fq * 8);
    if (kind == K_GATEUP) {
      char* act = (char*)(ws + WS_REG + R_ACT) + ((size_t)pm * 256 * DFF + (size_t)pn * 128) * 2;
      const unsigned vo = (rlane * DFF + clane) * 2u;
#pragma unroll
      for (int ai = 0; ai < 2; ++ai)
#pragma unroll
        for (int m = 0; m < 4; ++m) {
          f32x4 v0, v1;
#pragma unroll
          for (int e = 0; e < 4; ++e) {
            v0[e] = acc[ai][0][m][0][e] * acc[ai][1][m][0][e] * __builtin_amdgcn_rcpf(1.f + __builtin_amdgcn_exp2f(acc[ai][0][m][0][e]));
            v1[e] = acc[ai][0][m][1][e] * acc[ai][1][m][1][e] * __builtin_amdgcn_rcpf(1.f + __builtin_amdgcn_exp2f(acc[ai][0][m][1][e])); }
          *(u32x4*)(act + (vo + (unsigned)((ai * 128 + m * 16) * DFF * 2))) = pack8(v0, v1);
        }
    } else if (kind == K_RES) {
      const int mr = pm < 128 ? (pm >> 5) : 4;
      const float gate_mul = __int_as_float(pg8::rfl(__float_as_int(pd->gate_mul)));
      const char* gate = (const char*)((const float*)pg8::rflp((const char*)pd->mod) + (size_t)mr * NMOD + pg8::rfl(pd->gate_idx) * DM + pn * 256);
      const char* biasy = pg8::rflp((const char*)pd->biasy); const bool hasb = biasy != nullptr; if (hasb) biasy += (size_t)pn * 256 * 4;
      const char* xi = (const char*)(pm < 128 ? (const float*)pg8::rflp((const char*)pd->xin_lat) + (size_t)pm * 256 * DM : (const float*)pg8::rflp((const char*)pd->xin_ctx) + (size_t)(pm - 128) * 256 * DM) + (size_t)pn * 256 * 4;
      char* xo = (char*)(pm < 128 ? (float*)pg8::rflp((const char*)pd->xout_lat) + (size_t)pm * 256 * DM : (float*)pg8::rflp((const char*)pd->xout_ctx) + (size_t)(pm - 128) * 256 * DM) + (size_t)pn * 256 * 4;
      const unsigned vo = (rlane * DM + clane) * 4u, vc = clane * 4u;
      f32x4 gv[2][2], gb[2][2];
#pragma unroll
      for (int bj = 0; bj < 2; ++bj)
#pragma unroll
        for (int n = 0; n < 2; ++n) { const unsigned oc = vc + (unsigned)(bj * 512 + n * 16);
          gv[bj][n] = *(const f32x4*)(gate + oc) * gate_mul;
          gb[bj][n] = hasb ? gv[bj][n] * *(const f32x4*)(biasy + oc) : (f32x4){0.f, 0.f, 0.f, 0.f}; }
      f32x4 xa_[2][2], xb_[2][2];
#define RES_LD(BUF, g) do { _Pragma("unroll") for (int bj = 0; bj < 2; ++bj) _Pragma("unroll") for (int n = 0; n < 2; ++n) \
        BUF[bj][n] = *(const f32x4*)(xi + (vo + (unsigned)((((g) >> 2) * 128 + ((g) & 3) * 16) * DM * 4 + bj * 512 + n * 16))); } while (0)
#define RES_ST(BUF, g) do { _Pragma("unroll") for (int bj = 0; bj < 2; ++bj) _Pragma("unroll") for (int n = 0; n < 2; ++n) \
        *(f32x4*)(xo + (vo + (unsigned)((((g) >> 2) * 128 + ((g) & 3) * 16) * DM * 4 + bj * 512 + n * 16))) = BUF[bj][n] + gb[bj][n] + gv[bj][n] * acc[(g) >> 2][bj][(g) & 3][n]; \
        asm volatile("" ::: "memory"); } while (0)
      RES_LD(xa_, 0); RES_LD(xb_, 1); asm volatile("" ::: "memory");
      RES_ST(xa_, 0); RES_LD(xa_, 2); asm volatile("" ::: "memory");
      RES_ST(xb_, 1); RES_LD(xb_, 3); asm volatile("" ::: "memory");
      RES_ST(xa_, 2); RES_LD(xa_, 4); asm volatile("" ::: "memory");
      RES_ST(xb_, 3); RES_LD(xb_, 5); asm volatile("" ::: "memory");
      RES_ST(xa_, 4); RES_LD(xa_, 6); asm volatile("" ::: "memory");
      RES_ST(xb_, 5); RES_LD(xb_, 7); asm volatile("" ::: "memory");
      RES_ST(xa_, 6);
      RES_ST(xb_, 7);
#undef RES_LD
#undef RES_ST
    } else if (kind == K_RESP) {
      char* part = (char*)(ws + WS_PART) + ((size_t)u.kc * NCTX * DM + (size_t)(pm - 128) * 256 * DM + (size_t)pn * 256) * 4;
      const unsigned vo = (rlane * DM + clane) * 4u;
#pragma unroll
      for (int ai = 0; ai < 2; ++ai)
#pragma unroll
        for (int m = 0; m < 4; ++m) {
#pragma unroll
          for (int bj = 0; bj < 2; ++bj)
#pragma unroll
            for (int n = 0; n < 2; ++n) *(f32x4*)(part + (vo + (unsigned)((ai * 128 + m * 16) * DM * 4 + bj * 512 + n * 16))) = acc[ai][bj][m][n];
          asm volatile("" ::: "memory");
        }
    } else if (kind == K_INM) {
      const bool lat = pm < 128; const int b = lat ? (pm >> 5) : pm - 128;
      if (pn < 4) {
        const bool isK = pn >= 2; const int pt = pn & 1;
        const int nbase = lat ? (pm & 31) * 256 : SEQ;
        char* dst0 = (char*)(ws + WS_REG + (isK ? R_KS : R_QS)) + (((size_t)((b * 4 + 2 * pt) * 2)) * NKV + nbase) * 128;
        const char* rope = (const char*)(ws + WS_ROPE);
        const float sc = isK ? 1.f : QSCALE;
        const unsigned isub = (unsigned)(wc >> 1), colrot = (unsigned)(wc & 1);
        const unsigned vo = ((isub * NKV + rlane) * 64u + 32u * colrot + 8u * (unsigned)fq) * 2u;
#pragma unroll
        for (int ai = 0; ai < 2; ++ai) {
          f32x4 t0[4], t1[4];
#pragma unroll
          for (int m = 0; m < 4; ++m) {
            const unsigned npos = (unsigned)nbase + rlane + (unsigned)(ai * 128 + m * 16);
            const unsigned pos = lat ? (colrot ? (npos & 63u) : (npos >> 6)) : 128u;
            t0[m] = *(const f32x4*)(rope + (pos * 16u + 4u * (unsigned)fq) * 8u); t1[m] = *(const f32x4*)(rope + (pos * 16u + 4u * (unsigned)fq + 2u) * 8u); }
#pragma unroll
          for (int m = 0; m < 4; ++m) {
#pragma unroll
            for (int bj = 0; bj < 2; ++bj) {
              const f32x4 a0 = acc[ai][bj][m][0], a1 = acc[ai][bj][m][1];
              f32x4 v0, v1;
              v0[0] = (a0[0] * t0[m][0] - a0[1] * t0[m][1]) * sc; v0[1] = (a0[1] * t0[m][0] + a0[0] * t0[m][1]) * sc;
              v0[2] = (a0[2] * t0[m][2] - a0[3] * t0[m][3]) * sc; v0[3] = (a0[3] * t0[m][2] + a0[2] * t0[m][3]) * sc;
              v1[0] = (a1[0] * t1[m][0] - a1[1] * t1[m][1]) * sc; v1[1] = (a1[1] * t1[m][0] + a1[0] * t1[m][1]) * sc;
              v1[2] = (a1[2] * t1[m][2] - a1[3] * t1[m][3]) * sc; v1[3] = (a1[3] * t1[m][2] + a1[2] * t1[m][3]) * sc;
              *(u32x4*)(dst0 + (vo + (unsigned)((ai * 128 + m * 16) * 128) + (unsigned)bj * (unsigned)(2 * NKV * 128))) = pack8(v0, v1);
            } }
          asm volatile("" ::: "memory");
        }
      } else {
        char* yg = (char*)(ws + WS_REG + R_YGLU) + ((size_t)pm * 256 * 256 + (size_t)(pn - 4) * 128) * 2;
        const unsigned vo = (rlane * 256u + clane) * 2u;
#pragma unroll
        for (int ai = 0; ai < 2; ++ai)
#pragma unroll
          for (int m = 0; m < 4; ++m) {
            f32x4 v0, v1;
#pragma unroll
            for (int e = 0; e < 4; ++e) {
              v0[e] = acc[ai][0][m][0][e] * __builtin_amdgcn_rcpf(1.f + __builtin_amdgcn_exp2f(acc[ai][1][m][0][e])); v1[e] = acc[ai][0][m][1][e] * __builtin_amdgcn_rcpf(1.f + __builtin_amdgcn_exp2f(acc[ai][1][m][1][e])); }
            *(u32x4*)(yg + (vo + (unsigned)((ai * 128 + m * 16) * 512))) = pack8(v0, v1);
          }
      }
    } else {
      size_t ub; unsigned vl, sA, sM, sB; size_t roff;
      if (kind == K_VT) {
        const int b = pn < 128 ? (pn >> 5) : pn - 128, n0 = pn < 128 ? (pn & 31) * 256 : SEQ;
        roff = R_VT; ub = (((size_t)((b * 4 + 2 * pm) * 128)) * NKV + n0) * 2; vl = (rlane * NKV + (unsigned)(wc * 32 + (fq >> 1) * 16 + 4 * (fq & 1))) * 2u; sA = 128u * NKV * 2u; sM = 16u * NKV * 2u; sB = 256u;
      } else if (kind == K_FG) {
        const int b = pn >> 5;
        roff = R_GT; ub = ((size_t)(((b * 4 + 2 * pm) * 64) * 64 + 2 * (pn & 31))) * 512; vl = ((unsigned)fr * 64u * 256u + (unsigned)wr * 128u + clane) * 2u; sA = 64u * 64u * 256u * 2u; sM = 16u * 64u * 256u * 2u; sB = 512u;
      } else if (kind == K_FGC) {
        roff = R_GTC; ub = ((size_t)((pn * 4 + 2 * pm) * 64)) * 1024; vl = ((unsigned)fr * 512u + (unsigned)wr * 256u + clane) * 2u; sA = 64u * 512u * 2u; sM = 16u * 512u * 2u; sB = 256u;
      } else if (kind == K_STA) {
        roff = R_T; ub = ((size_t)(4 * pn * 128 * 2)) * 128; vl = ((((unsigned)(wc >> 1) * 128u + rlane) * 2u) * 64u + (unsigned)(wc & 1) * 32u + (unsigned)fq * 8u) * 2u; sA = 128u; sM = 16u * 2u * 64u * 2u; sB = 2u * 128u * 2u * 64u * 2u;
      } else if (kind == K_STB) {
        roff = R_CAT; ub = (((size_t)(pn * SEQ + 4 * pm)) * DM + 768) * 2; vl = (((unsigned)wr + 128u * (unsigned)fr) * DM + clane) * 2u; sA = 2u * DM * 2u; sM = 128u * 16u * DM * 2u; sB = 256u;
      } else {
        roff = R_CAT; ub = (((size_t)(NLAT + pn * CTXL)) * DM + 768) * 2; vl = (rlane * DM + clane) * 2u; sA = 128u * DM * 2u; sM = 16u * DM * 2u; sB = 256u;
      }
      char* dst0 = (char*)(ws + WS_REG + roff) + ub;
#pragma unroll
      for (int ai = 0; ai < 2; ++ai)
#pragma unroll
        for (int m = 0; m < 4; ++m) {
#pragma unroll
          for (int bj = 0; bj < 2; ++bj) {
            const u32x4 w = pack8(acc[ai][bj][m][0], acc[ai][bj][m][1]);
            char* d_ = dst0 + (vl + (unsigned)ai * sA + (unsigned)m * sM + (unsigned)bj * sB);
            if (kind == K_VT) { *(u32x2*)d_ = (u32x2){w.x, w.y}; *(u32x2*)(d_ + 16) = (u32x2){w.z, w.w}; }
            else *(u32x4*)d_ = w;
          }
          asm volatile("" ::: "memory");
        }
    }
  }
};

struct Params { const float* in[31]; float* out; unsigned char* ws; };
struct DP {
  const float* LAS* tab; unsigned char* ws;
  __device__ __forceinline__ const float* in_(int i) const { return (const float*)pg8::rflp((const char*)tab[i]); }
};
enum { I_X = 0, I_C, I_CTX, I_CCTX, I_WADA, I_BADA, I_GF1, I_GMIX, I_GF2, I_W1G, I_W1U, I_W1D, I_W2G, I_W2U, I_W2D, I_WIN, I_LQ1, I_LK1, I_LQ2, I_LK2,
       I_GSUB, I_WDW, I_BDW, I_GCLN, I_BCLN, I_WPW, I_BPW, I_WF, I_BF, I_WOUT, I_GFIN };

__device__ __forceinline__ int dperm(int p) { const int pi = p >> 1, w = p & 1; return pi < 16 ? pi + 16 * w : 32 + (pi - 16) + 16 * w; }

__device__ __forceinline__ void p0_transpose(const DP& p, LAS unsigned char* lds, int it, int tid, int lane, int wid) {
  const int l = it / 1216; int r = it % 1216;
  unsigned char* wl = p.ws + WS_W + (size_t)l * WL;
  const float* src; int srcld, scol, n0, k0, dstld; bf16_t* dst; float scl = 1.f;
  if (r < 352 || (r >= 528 && r < 880)) {
    const bool second = r >= 528; if (second) r -= 528;
    n0 = (r / 4) * 64; k0 = (r % 4) * 256; const int n = n0 + lane; const int half = (n >> 7) & 1;
    const float* wg = p.in_(second ? I_W2G : I_W1G) + (size_t)l * 1024 * DFF; const float* wu = p.in_(second ? I_W2U : I_W1U) + (size_t)l * 1024 * DFF;
    src = half ? wu : wg; srcld = DFF; scol = (n >> 8) * 128 + (n & 127); dst = (bf16_t*)(wl + (second ? W_FF2A : W_FF1A)); dstld = 1024;
    scl = half ? (-1.0f / LOG2E) : -LOG2E;
  } else if (r < 528 || (r >= 880 && r < 1056)) {
    const bool second = r >= 880; r -= second ? 880 : 352;
    n0 = (r / 11) * 64; k0 = (r % 11) * 256; src = p.in_(second ? I_W2D : I_W1D) + (size_t)l * DFF * 1024; srcld = 1024; scol = n0 + lane;
    dst = (bf16_t*)(wl + (second ? W_DN2 : W_DN1)); dstld = DFF;
  } else if (r < 1152) {
    r -= 1056; n0 = (r / 4) * 64; k0 = (r % 4) * 256; const int n = n0 + lane; src = p.in_(I_WIN) + (size_t)l * 1024 * 2304; srcld = 2304;
    if (n < 1024) scol = (n & ~63) + dperm(n & 63); else { const int nn = n - 1024; scol = 1536 + ((nn >> 7) & 1) * 256 + (nn >> 8) * 128 + (nn & 127); }
    if (n0 >= 1024 && (((n0 - 1024) >> 7) & 1)) scl = -LOG2E;
    dst = (bf16_t*)(wl + W_INM); dstld = 1024;
  } else if (r < 1184) {
    r -= 1152; n0 = (r / 4) * 64; k0 = (r % 4) * 256; src = p.in_(I_WIN) + (size_t)l * 1024 * 2304; srcld = 2304; scol = 1024 + n0 + lane;
    dst = (bf16_t*)(wl + W_WV); dstld = 1024;
  } else {
    r -= 1184; n0 = (r / 2) * 64; k0 = (r % 2) * 256; src = p.in_(I_WOUT) + (size_t)l * 1024 * 1024; srcld = 1024; scol = n0 + lane;
    dst = (bf16_t*)(wl + W_WOUT); dstld = 1024;
  }
  LAS float* tile = (LAS float*)lds;
  const float* sp = src + (size_t)(k0 + wid) * srcld + scol;
  { float tt_[32];
#pragma unroll
    for (int i = 0; i < 32; ++i) tt_[i] = sp[(size_t)(8 * i) * srcld];
#pragma unroll
    for (int i = 0; i < 32; ++i) tile[(wid + 8 * i) * 65 + lane] = tt_[i]; }
  __syncthreads();
  { const int row = tid >> 3, ch = tid & 7;
#pragma unroll
    for (int c = 0; c < 4; ++c) { const LAS float* s = tile + (8 * (ch + 8 * c)) * 65 + row;
      u32x4 o; o.x = cvtpk(s[0] * scl, s[65] * scl); o.y = cvtpk(s[130] * scl, s[195] * scl); o.z = cvtpk(s[260] * scl, s[325] * scl); o.w = cvtpk(s[390] * scl, s[455] * scl);
      *(u32x4*)(dst + (size_t)(n0 + row) * dstld + k0 + 8 * (ch + 8 * c)) = o; } }
  __syncthreads();
}

__device__ __forceinline__ void p0_wfour(const DP& p, LAS unsigned char* lds, int it, int tid, int lane, int wid) {
  const int l = it >> 6, g = (it >> 4) & 3, k0 = (it & 15) * 64;
  LAS float* tile = (LAS float*)lds; LAS float* cs = tile + 64 * 65; LAS float* sn = cs + 64;
  const float* win = p.in_(I_WIN) + (size_t)l * 1024 * 2304;
#pragma unroll
  for (int i = 0; i < 8; ++i) { const int kk = wid + 8 * i; tile[kk * 65 + lane] = win[(size_t)(k0 + kk) * 2304 + 2048 + 64 * g + lane]; }
  if (tid < 64) { cs[tid] = __builtin_amdgcn_cosf((float)tid * (1.f / 64.f)); sn[tid] = __builtin_amdgcn_sinf((float)tid * (1.f / 64.f)); }
  __syncthreads();
  bf16_t* dst = (bf16_t*)(p.ws + WS_W + (size_t)l * WL + W_WFR);
  const int kk = lane;
  for (int i = 0; i < 16; ++i) {
    const int fidx = wid + 8 * i, comp = fidx >> 6, j = fidx & 63; float s = 0.f;
    for (int c = 0; c < 64; ++c) { const int mi = (j * c) & 63; const float tw = comp ? -sn[mi] : cs[mi]; s += tile[kk * 65 + c] * tw; }
    dst[(size_t)(g * 128 + fidx) * 1024 + k0 + kk] = (bf16_t)(cvtpk(s, 0.f) & 0xffffu);
  }
  __syncthreads();
}

__device__ __forceinline__ void p0_woutfold(const DP& p, LAS unsigned char* lds, int it, int tid, int lane, int wid) {
  const int l = it >> 6, which = (it >> 5) & 1, n0 = ((it >> 1) & 15) * 64, kh = it & 1;
  LAS float* wo = (LAS float*)lds;
  LAS float* w2s = wo + 256 * 64 + wid * 2048;
  const float* wout = p.in_(I_WOUT) + (size_t)l * 1024 * 1024 + (size_t)(512 + 256 * which) * 1024;
  { float wt_[32];
#pragma unroll
    for (int i = 0; i < 32; ++i) wt_[i] = wout[(size_t)(wid + 8 * i) * 1024 + n0 + lane];
#pragma unroll
    for (int i = 0; i < 32; ++i) wo[(wid + 8 * i) * 64 + lane] = wt_[i]; }
  __syncthreads();
  const float* W2 = (which ? p.in_(I_WF) : p.in_(I_WPW)) + (size_t)l * 256 * 256;
  bf16_t* dst = (bf16_t*)(p.ws + WS_W + (size_t)l * WL + W_WOUT);
  for (int i8 = 0; i8 < 2; ++i8) {
    const int kp0 = kh * 128 + wid * 16 + i8 * 8;
#pragma unroll
    for (int e = 0; e < 8; ++e) *(LAS f32x4*)(w2s + e * 256 + 4 * lane) = *(const f32x4*)(W2 + (size_t)(kp0 + e) * 256 + 4 * lane);
    asm volatile("s_waitcnt vmcnt(0) lgkmcnt(0)" ::: "memory");
    float a[8];
#pragma unroll
    for (int e = 0; e < 8; ++e) a[e] = 0.f;
    for (int j = 0; j < 256; j += 4) {
      const float w0 = wo[j * 64 + lane], w1 = wo[(j + 1) * 64 + lane], w2 = wo[(j + 2) * 64 + lane], w3 = wo[(j + 3) * 64 + lane];
#pragma unroll
      for (int e = 0; e < 8; ++e) { const f32x4 c = *(const LAS f32x4*)(w2s + e * 256 + j); a[e] += c[0] * w0 + c[1] * w1 + c[2] * w2 + c[3] * w3; }
    }
    u32x4 o; o.x = cvtpk(a[0], a[1]); o.y = cvtpk(a[2], a[3]); o.z = cvtpk(a[4], a[5]); o.w = cvtpk(a[6], a[7]);
    *(u32x4*)(dst + (size_t)(n0 + lane) * 1024 + 512 + 256 * which + kp0) = o;
    asm volatile("s_waitcnt lgkmcnt(0)" ::: "memory");
  }
  __syncthreads();
}

__device__ __forceinline__ void p0_biasy(const DP& p, int l, int tid) {
  const float* wout = p.in_(I_WOUT) + (size_t)l * 1024 * 1024; const float* bpw = p.in_(I_BPW) + l * 256; const float* bf = p.in_(I_BF) + l * 256;
  float* by = (float*)(p.ws + WS_BIASY) + l * 1024;
  for (int n = tid; n < 1024; n += 512) { float s = 0.f;
    for (int j = 0; j < 256; ++j) s += bpw[j] * wout[(size_t)(512 + j) * 1024 + n] + bf[j] * wout[(size_t)(768 + j) * 1024 + n];
    by[n] = s; }
}

__device__ __forceinline__ void p0_mod(const DP& p, LAS unsigned char* lds, int it, int tid, int lane, int wid) {
  const int l = it / 144, cb = it % 144;
  LAS float* s = (LAS float*)lds;
  LAS float* red = s + 5 * 1024;
  for (int i = tid; i < 5 * 1024; i += 512) { const int r = i >> 10, k = i & 1023; const float v = r < 4 ? p.in_(I_C)[r * 1024 + k] : p.in_(I_CCTX)[k]; s[i] = silu_f(v); }
  __syncthreads();
  const float* w = p.in_(I_WADA) + (size_t)l * 1024 * NMOD + cb * 64 + lane;
  float a0 = 0.f, a1 = 0.f, a2 = 0.f, a3 = 0.f, a4 = 0.f;
#pragma unroll 8
  for (int i = 0; i < 128; ++i) { const int k = wid + 8 * i; const float wv = w[(size_t)k * NMOD];
    a0 += s[k] * wv; a1 += s[1024 + k] * wv; a2 += s[2048 + k] * wv; a3 += s[3072 + k] * wv; a4 += s[4096 + k] * wv; }
  red[(wid * 5 + 0) * 64 + lane] = a0; red[(wid * 5 + 1) * 64 + lane] = a1; red[(wid * 5 + 2) * 64 + lane] = a2; red[(wid * 5 + 3) * 64 + lane] = a3; red[(wid * 5 + 4) * 64 + lane] = a4;
  __syncthreads();
  if (tid < 320) { const int r = tid >> 6, col = tid & 63; float v = p.in_(I_BADA)[(size_t)l * NMOD + cb * 64 + col];
#pragma unroll
    for (int w8 = 0; w8 < 8; ++w8) v += red[(w8 * 5 + r) * 64 + col];
    ((float*)(p.ws + WS_MOD))[((size_t)l * 5 + r) * NMOD + cb * 64 + col] = v; }
  __syncthreads();
}

__device__ __forceinline__ void p0_tables(const DP& p, int it, int tid) {
  if (it < 1024) {
    const int idx = it * 512 + tid, R = idx >> 6, C0 = (idx & 63) * 8;
    const int q = R >> 8, a = (R >> 6) & 3, k2 = R & 63, k = 4 * q + a + 128 * k2;
    const int ap = C0 >> 7, comp = (C0 >> 6) & 1, n20 = C0 & 63;
    float v[8];
#pragma unroll
    for (int e = 0; e < 8; ++e) { const int mi = ((n20 + e) * k) & 8191; const float fr = (float)mi * (1.f / 8192.f);
      const float t = comp ? __builtin_amdgcn_sinf(fr) : __builtin_amdgcn_cosf(fr); v[e] = (ap == a) ? t * 0.001381067932f : 0.f; }
    u32x4 o; o.x = cvtpk(v[0], v[1]); o.y = cvtpk(v[2], v[3]); o.z = cvtpk(v[4], v[5]); o.w = cvtpk(v[6], v[7]);
    *(u32x4*)((bf16_t*)(p.ws + WS_EBD) + (size_t)R * 512 + C0) = o;
  } else if (it < 1040) {
    const int idx = (it - 1024) * 512 + tid, row = idx >> 5, C0 = (idx & 31) * 8;
    const int compo = row >> 7, k1 = row & 127, comp = C0 >> 7, n10 = C0 & 127;
    float v[8];
#pragma unroll
    for (int e = 0; e < 8; ++e) { const int mi = (k1 * (n10 + e)) & 127; const float fr = (float)mi * (1.f / 128.f);
      const float cc = __builtin_amdgcn_cosf(fr), ss = __builtin_amdgcn_sinf(fr); v[e] = compo == 0 ? (comp == 0 ? cc : ss) : (comp == 0 ? -ss : cc); }
    u32x4 o; o.x = cvtpk(v[0], v[1]); o.y = cvtpk(v[2], v[3]); o.z = cvtpk(v[4], v[5]); o.w = cvtpk(v[6], v[7]);
    *(u32x4*)((bf16_t*)(p.ws + WS_DA) + (size_t)row * 256 + C0) = o;
  } else if (it < 1072) {
    const int idx = (it - 1040) * 512 + tid, k = idx >> 6, C0 = (idx & 63) * 8, comp = C0 >> 8, n0 = C0 & 255;
    float v[8];
#pragma unroll
    for (int e = 0; e < 8; ++e) { const int mi = (k * (n0 + e)) & 255; const float fr = (float)mi * (1.f / 256.f);
      v[e] = (comp ? __builtin_amdgcn_sinf(fr) : __builtin_amdgcn_cosf(fr)) * (1.f / 128.f); }
    u32x4 o; o.x = cvtpk(v[0], v[1]); o.y = cvtpk(v[2], v[3]); o.z = cvtpk(v[4], v[5]); o.w = cvtpk(v[6], v[7]);
    *(u32x4*)((bf16_t*)(p.ws + WS_E256) + (size_t)k * 512 + C0) = o;
  } else {
    f32x2* rope = (f32x2*)(p.ws + WS_ROPE);
    for (int i = tid; i < 129 * 16; i += 512) { const int pos = i >> 4, fi = i & 15;
      float cc = 1.f, ss = 0.f;
      if (pos < 128) { const float inv = __builtin_amdgcn_exp2f(-(float)fi * (13.287712379549449f / 16.f)); const float ang = (float)pos * inv;
        const double turns = (double)ang * 0.15915494309189535; const float fr = (float)(turns - (double)(long long)turns);
        cc = __builtin_amdgcn_cosf(fr); ss = __builtin_amdgcn_sinf(fr); }
      rope[i] = (f32x2){cc, ss}; }
  }
}

__device__ __forceinline__ void norm_row(const float* xr, float* xwb, const int nc_pend_ks, const float* nc_gate, const float nc_gmul, const float* nc_bias, const unsigned char* ws, int cidx, const f32x4 (&ca)[4], const f32x4 (&cb)[4], bf16_t* ho, bf16_t* hpo, int lane) {
  f32x4 v[4];
#pragma unroll
  for (int j = 0; j < 4; ++j) v[j] = *(const f32x4*)(xr + 4 * lane + 256 * j);
  if (nc_pend_ks > 0) {
    f32x4 s4[4];
#pragma unroll
    for (int j = 0; j < 4; ++j) s4[j] = nc_bias ? *(const f32x4*)(nc_bias + 4 * lane + 256 * j) : (f32x4){0.f, 0.f, 0.f, 0.f};
    const float* pp = (const float*)(ws + WS_PART) + (size_t)cidx * DM + 4 * lane;
    for (int kc0 = 0; kc0 < nc_pend_ks; kc0 += 4) {
      f32x4 t4[4][4];
#pragma unroll
      for (int kk = 0; kk < 4; ++kk) { const int kc = (kc0 + kk < nc_pend_ks) ? kc0 + kk : kc0;
#pragma unroll
        for (int j = 0; j < 4; ++j) t4[kk][j] = *(const f32x4*)(pp + (size_t)kc * NCTX * DM + 256 * j); }
#pragma unroll
      for (int kk = 0; kk < 4; ++kk) { if (kc0 + kk < nc_pend_ks) {
#pragma unroll
        for (int j = 0; j < 4; ++j) s4[j] += t4[kk][j]; } }
    }
#pragma unroll
    for (int j = 0; j < 4; ++j) { v[j] += *(const f32x4*)(nc_gate + 4 * lane + 256 * j) * nc_gmul * s4[j]; *(f32x4*)(xwb + 4 * lane + 256 * j) = v[j]; }
  }
  float ss = 0.f;
#pragma unroll
  for (int j = 0; j < 4; ++j) ss += (v[j][0] * v[j][0] + v[j][1] * v[j][1]) + (v[j][2] * v[j][2] + v[j][3] * v[j][3]);
  const float rstd = 1.0f / sqrtf(wave_sum(ss, lane) * (1.f / DM) + EPS);
  u32x2 o[4];
#pragma unroll
  for (int j = 0; j < 4; ++j) { const f32x4 h = v[j] * rstd * ca[j] + cb[j]; o[j].x = cvtpk(h[0], h[1]); o[j].y = cvtpk(h[2], h[3]); }
#pragma unroll
  for (int j = 0; j < 4; ++j) *(u32x2*)(ho + 4 * lane + 256 * j) = o[j];
  if (hpo) {
#pragma unroll
    for (int j = 0; j < 4; ++j) *(u32x2*)(hpo + 4 * lane + 256 * j) = o[j]; }
}
__device__ __forceinline__ void norm_phase(const float* x_lat, const float* x_ctx, float* xc_wb, const float* g, const float* mod, int ish, bf16_t* hbf, bf16_t* hbfp, bool with_ctx,
                                           const int nc_pend_ks, const float* nc_gate, const float nc_gmul, const float* nc_bias, const unsigned char* ws, int gw0, int nwaves, int lane) {
  f32x4 ca[4], cb[4];
  for (int gw = gw0; gw < NLAT / 16; gw += nwaves) {
    const int r0 = gw * 16, mr = r0 >> 13; const float* sh = mod + (size_t)mr * NMOD + ish * DM; const float* sc = sh + DM;
#pragma unroll
    for (int j = 0; j < 4; ++j) { const int c = 4 * lane + 256 * j; const f32x4 gv = *(const f32x4*)(g + c), sv = *(const f32x4*)(sc + c); ca[j] = gv * (sv + 1.f); cb[j] = *(const f32x4*)(sh + c); }
    for (int r = r0; r < r0 + 16; ++r) {
      bf16_t* hp = nullptr;
      if (hbfp) { const int b = r >> 13, n = r & 8191, rho = (b << 13) + ((n & 63) << 7) + (n >> 6); hp = hbfp + (size_t)rho * DM; }
      norm_row(x_lat + (size_t)r * DM, nullptr, 0, nullptr, 0.f, nullptr, ws, 0, ca, cb, hbf + (size_t)r * DM, hp, lane);
    }
  }
  if (with_ctx) for (int gw = gw0; gw < NCTX; gw += nwaves) {
    const float* sh = mod + (size_t)4 * NMOD + ish * DM; const float* sc = sh + DM;
#pragma unroll
    for (int j = 0; j < 4; ++j) { const int c = 4 * lane + 256 * j; const f32x4 gv = *(const f32x4*)(g + c), sv = *(const f32x4*)(sc + c); ca[j] = gv * (sv + 1.f); cb[j] = *(const f32x4*)(sh + c); }
    norm_row(x_ctx + (size_t)gw * DM, xc_wb + (size_t)gw * DM, nc_pend_ks, nc_gate, nc_gmul, nc_bias, ws, gw, ca, cb, hbf + (size_t)(NLAT + gw) * DM, nullptr, lane);
  }
}

constexpr int AT_K = 9216, AT_V = 18432, AT_STAGE = 2 * AT_K + AT_V;
constexpr float AT_THR = 8.0f;
__device__ __forceinline__ void attn_unit(LAS unsigned char* lds, const unsigned char* ws, int b, int h, int q0, int kbeg, int nkt, int catrow0,
                                          float lam, float outscale, const float* gsub, int tid, int lane, int wid) {
  const bf16_t* Qs = (const bf16_t*)(ws + WS_REG + R_QS); const bf16_t* Ks = (const bf16_t*)(ws + WS_REG + R_KS); const bf16_t* Vt = (const bf16_t*)(ws + WS_REG + R_VT);
  const int isub = wid >> 2, qw = q0 + 32 * (wid & 3), l32 = lane & 31, hh = lane >> 5;
  const bool defer = isub == 1;
  bf16x8 qf[4];
  { const bf16_t* qp = Qs + ((size_t)(((b * 4 + h) * 2 + isub)) * NKV + qw + l32) * 64 + 8 * hh;
#pragma unroll
    for (int ks = 0; ks < 4; ++ks) qf[ks] = *(const bf16x8*)(qp + 16 * ks); }
  const int krow = tid >> 3, kch = tid & 7;
  const bf16_t* ksrc0 = Ks + ((size_t)(((b * 4 + h) * 2 + 0)) * NKV + kbeg + krow) * 64 + kch * 8;
  const bf16_t* ksrc1 = ksrc0 + (size_t)NKV * 64;
  const bf16_t* vsrc0 = Vt + ((size_t)((b * 4 + h) * 128 + krow)) * NKV + kbeg + kch * 8;
  const bf16_t* vsrc1 = vsrc0 + (size_t)64 * NKV;
  const int kdst = krow * 144 + kch * 16, vdst = 2 * AT_K + krow * 144 + kch * 16;
  u32x4 pk0, pk1, pv0, pv1;
  pk0 = *(const u32x4*)ksrc0; pk1 = *(const u32x4*)ksrc1; pv0 = *(const u32x4*)vsrc0; pv1 = *(const u32x4*)vsrc1;
#define AT_WRITE(soff) do { LAS unsigned char* sb_ = lds + (soff); \
    *(LAS u32x4*)(sb_ + kdst) = pk0; *(LAS u32x4*)(sb_ + AT_K + kdst) = pk1; \
    *(LAS u32x4*)(sb_ + vdst) = pv0; *(LAS u32x4*)(sb_ + vdst + 64 * 144) = pv1; } while (0)
#define AT_PV(soff) do { const LAS unsigned char* vb_ = lds + (soff) + 2 * AT_K + l32 * 144 + hh * 16; \
    _Pragma("unroll") for (int d = 0; d < 4; ++d) { _Pragma("unroll") for (int s4 = 0; s4 < 4; ++s4) { \
      const bf16x8 vv_ = *(const LAS bf16x8*)(vb_ + d * 32 * 144 + s4 * 32); \
      O[d] = __builtin_amdgcn_mfma_f32_32x32x16_bf16(vv_, pf[s4], O[d], 0, 0, 0); } } } while (0)
  AT_WRITE(0);
  __syncthreads();
  f32x16 O[4];
#pragma unroll
  for (int d = 0; d < 4; ++d)
#pragma unroll
    for (int r = 0; r < 16; ++r) O[d][r] = 0.f;
  f32x16 negm;
#pragma unroll
  for (int r = 0; r < 16; ++r) negm[r] = 0.f;
  float lrun = 0.f;
  bf16x8 pf[4];
#pragma unroll
  for (int s4 = 0; s4 < 4; ++s4) pf[s4] = (bf16x8){0, 0, 0, 0, 0, 0, 0, 0};
  int s_prev = 2 * AT_STAGE, s_cur = 0, s_nxt = AT_STAGE;
  for (int t = 0; t <= nkt; ++t) {
    const bool more = (t + 1 < nkt), have = (t < nkt);
    if (more) { const size_t ko = (size_t)(t + 1) * 64 * 64, vo = (size_t)(t + 1) * 64;
      pk0 = *(const u32x4*)(ksrc0 + ko); pk1 = *(const u32x4*)(ksrc1 + ko); pv0 = *(const u32x4*)(vsrc0 + vo); pv1 = *(const u32x4*)(vsrc1 + vo); }
    if (defer && t > 0) AT_PV(s_prev);
    if (have) {
      const LAS unsigned char* kb = lds + s_cur + isub * AT_K + l32 * 144 + hh * 16;
      f32x16 S0 = negm, S1 = negm;
#pragma unroll
      for (int ks = 0; ks < 4; ++ks) {
        const bf16x8 k0 = *(const LAS bf16x8*)(kb + ks * 32), k1 = *(const LAS bf16x8*)(kb + 32 * 144 + ks * 32);
        S0 = __builtin_amdgcn_mfma_f32_32x32x16_bf16(k0, qf[ks], S0, 0, 0, 0);
        S1 = __builtin_amdgcn_mfma_f32_32x32x16_bf16(k1, qf[ks], S1, 0, 0, 0);
      }
      float mx = fmaxf(fmaxf(S0[0], S0[1]), S1[0]);
#pragma unroll
      for (int r = 2; r < 16; r += 2) mx = fmaxf(fmaxf(mx, S0[r]), S0[r + 1]);
#pragma unroll
      for (int r = 1; r < 15; r += 2) mx = fmaxf(fmaxf(mx, S1[r]), S1[r + 1]);
      mx = fmaxf(mx, S1[15]);
      mx = fmaxf(mx, shx(mx, 32, lane));
      if (t == 0 || __any(mx > AT_THR)) {
        const float dl = (t == 0) ? mx : fmaxf(mx, 0.f);
        const float f = (t == 0) ? 1.f : __builtin_amdgcn_exp2f(-dl);
        lrun *= f;
#pragma unroll
        for (int d = 0; d < 4; ++d)
#pragma unroll
          for (int r = 0; r < 16; ++r) O[d][r] *= f;
#pragma unroll
        for (int r = 0; r < 16; ++r) { S0[r] -= dl; S1[r] -= dl; negm[r] -= dl; }
      }
      float ps = 0.f;
#pragma unroll
      for (int r = 0; r < 16; ++r) { S0[r] = __builtin_amdgcn_exp2f(S0[r]); S1[r] = __builtin_amdgcn_exp2f(S1[r]); ps += S0[r] + S1[r]; }
      lrun += ps;
      { u32x4 w;
        w.x = cvtpk(S0[0], S0[1]); w.y = cvtpk(S0[2], S0[3]); w.z = cvtpk(S0[4], S0[5]); w.w = cvtpk(S0[6], S0[7]); pf[0] = __builtin_bit_cast(bf16x8, w);
        w.x = cvtpk(S0[8], S0[9]); w.y = cvtpk(S0[10], S0[11]); w.z = cvtpk(S0[12], S0[13]); w.w = cvtpk(S0[14], S0[15]); pf[1] = __builtin_bit_cast(bf16x8, w);
        w.x = cvtpk(S1[0], S1[1]); w.y = cvtpk(S1[2], S1[3]); w.z = cvtpk(S1[4], S1[5]); w.w = cvtpk(S1[6], S1[7]); pf[2] = __builtin_bit_cast(bf16x8, w);
        w.x = cvtpk(S1[8], S1[9]); w.y = cvtpk(S1[10], S1[11]); w.z = cvtpk(S1[12], S1[13]); w.w = cvtpk(S1[14], S1[15]); pf[3] = __builtin_bit_cast(bf16x8, w); }
      if (!defer) AT_PV(s_cur);
    }
    if (more) AT_WRITE(s_nxt);
    if (have) __syncthreads();
    { const int tmp = s_prev; s_prev = s_cur; s_cur = s_nxt; s_nxt = tmp; }
  }
  __syncthreads();
#undef AT_WRITE
#undef AT_PV
  const float ltot = lrun + shx(lrun, 32, lane);
  const float rl = 1.f / ltot;
  LAS float* X = (LAS float*)lds;
  const int q = 32 * (wid & 3) + l32;
  if (isub == 1) {
#pragma unroll
    for (int d = 0; d < 4; ++d)
#pragma unroll
      for (int g4 = 0; g4 < 4; ++g4) { const int dv = 32 * d + 8 * g4 + 4 * hh;
        *(LAS f32x4*)(X + q * 132 + dv) = (f32x4){O[d][4 * g4] * rl, O[d][4 * g4 + 1] * rl, O[d][4 * g4 + 2] * rl, O[d][4 * g4 + 3] * rl}; }
  }
  __syncthreads();
  if (isub == 0) {
    float ssq = 0.f;
#pragma unroll
    for (int d = 0; d < 4; ++d)
#pragma unroll
      for (int g4 = 0; g4 < 4; ++g4) { const int dv = 32 * d + 8 * g4 + 4 * hh; const f32x4 o1 = *(const LAS f32x4*)(X + q * 132 + dv);
#pragma unroll
        for (int e = 0; e < 4; ++e) { const float v = O[d][4 * g4 + e] * rl - lam * o1[e]; O[d][4 * g4 + e] = v; ssq += v * v; } }
    ssq += shx(ssq, 32, lane);
    const float rn = outscale / sqrtf(ssq * (1.f / 128.f) + EPS);
    bf16_t* crow = (bf16_t*)(ws + WS_REG + R_CAT) + (size_t)(catrow0 + q) * DM + h * 128;
#pragma unroll
    for (int d = 0; d < 4; ++d)
#pragma unroll
      for (int g4 = 0; g4 < 4; ++g4) { const int dv = 32 * d + 8 * g4 + 4 * hh; const f32x4 gv = *(const f32x4*)(gsub + dv);
        u32x2 o; o.x = cvtpk(O[d][4 * g4] * rn * gv[0], O[d][4 * g4 + 1] * rn * gv[1]); o.y = cvtpk(O[d][4 * g4 + 2] * rn * gv[2], O[d][4 * g4 + 3] * rn * gv[3]);
        *(u32x2*)(crow + dv) = o; }
  }
  __syncthreads();
}

__device__ __forceinline__ void conv_unit(LAS unsigned char* lds, const DP& p, int l, int row0, int seq_lo, int seq_hi, int tid, int lane, int wid) {
  LAS unsigned char* yl = lds; LAS float* wl = (LAS float*)(lds + 48128);
  const bf16_t* yg = (const bf16_t*)(p.ws + WS_REG + R_YGLU);
  const float* wdw = p.in_(I_WDW) + (size_t)l * 31 * 256;
  {
    u32x4 yv_[6]; f32x4 wv_[4];
#pragma unroll
    for (int k = 0; k < 6; ++k) { const int i = tid + 512 * k, rr = i >> 5, ch = i & 31, r = row0 - 15 + rr;
      yv_[k] = (u32x4){0u, 0u, 0u, 0u}; if (i < 94 * 32 && r >= seq_lo && r < seq_hi) yv_[k] = *(const u32x4*)(yg + (size_t)r * 256 + ch * 8); }
#pragma unroll
    for (int k = 0; k < 4; ++k) { const int i = tid + 512 * k; wv_[k] = (f32x4){0.f, 0.f, 0.f, 0.f}; if (i < 31 * 64) wv_[k] = *(const f32x4*)(wdw + i * 4); }
#pragma unroll
    for (int k = 0; k < 6; ++k) { const int i = tid + 512 * k, rr = i >> 5, ch = i & 31; if (i < 94 * 32) *(LAS u32x4*)(yl + rr * 512 + ch * 16) = yv_[k]; }
#pragma unroll
    for (int k = 0; k < 4; ++k) { const int i = tid + 512 * k; if (i < 31 * 64) *(LAS f32x4*)(wl + i * 4) = wv_[k]; }
  }
  __syncthreads();
  f32x4 acc[8];
  { const f32x4 bd = *(const f32x4*)(p.in_(I_BDW) + l * 256 + 4 * lane);
#pragma unroll
    for (int i = 0; i < 8; ++i) acc[i] = bd; }
#pragma unroll 1
  for (int j = 0; j < 31; ++j) {
    const f32x4 wv = *(const LAS f32x4*)(wl + j * 256 + 4 * lane);
    const LAS unsigned char* yp = yl + (8 * wid + j) * 512 + lane * 8;
#pragma unroll
    for (int i = 0; i < 8; ++i) {
      const u32x2 raw = *(const LAS u32x2*)(yp + i * 512);
      const f32x4 yv = {bf2f(raw.x & 0xffffu), bf2f(raw.x >> 16), bf2f(raw.y & 0xffffu), bf2f(raw.y >> 16)};
      acc[i] += yv * wv;
    }
  }
  const f32x4 gl = *(const f32x4*)(p.in_(I_GCLN) + l * 256 + 4 * lane), bl = *(const f32x4*)(p.in_(I_BCLN) + l * 256 + 4 * lane);
  bf16_t* cat = (bf16_t*)(p.ws + WS_REG + R_CAT);
#pragma unroll
  for (int i = 0; i < 8; ++i) {
    const f32x4 v = acc[i];
    const float mu = wave_sum((v[0] + v[1]) + (v[2] + v[3]), lane) * (1.f / 256.f);
    const f32x4 d = v - mu;
    const float var = wave_sum((d[0] * d[0] + d[1] * d[1]) + (d[2] * d[2] + d[3] * d[3]), lane) * (1.f / 256.f);
    const float rs = 1.0f / sqrtf(var + EPS);
    const f32x4 y = d * rs * gl + bl;
    u32x2 o; o.x = cvtpk(silu_f(y[0]), silu_f(y[1])); o.y = cvtpk(silu_f(y[2]), silu_f(y[3]));
    *(u32x2*)(cat + (size_t)(row0 + 8 * wid + i) * DM + 512 + 4 * lane) = o;
  }
  __syncthreads();
}


#define XB_TMO      128
#define XB_XCNT(j)  (256  + 64 * (j))
#define XB_XSUB(j)  (1280 + 64 * (j))
#define XB_XGEN(j)  (2304 + 64 * (j))
#define XB_TOP      3328
#define XB_TOPGEN   3392
#define XCD_BAR_WORDS 3456
#define XB_SPIN_CAP (1u << 22)
__device__ __forceinline__ unsigned xb_ld(unsigned* p)              { return __hip_atomic_load(p, __ATOMIC_RELAXED, __HIP_MEMORY_SCOPE_AGENT); }
__device__ __forceinline__ unsigned xb_add(unsigned* p, unsigned v) { return __hip_atomic_fetch_add(p, v, __ATOMIC_RELAXED, __HIP_MEMORY_SCOPE_AGENT); }
__device__ __forceinline__ unsigned xb_xcc_id() { return (unsigned)__builtin_amdgcn_s_getreg((3 << 11) | 20) & 0xFu; }
#define XB_SPIN(cond, bar) do { unsigned _sp = 0; while (cond) { __builtin_amdgcn_s_sleep(1); \
    if ((++_sp & 255u) == 0u) { if (xb_ld(&(bar)[XB_TMO])) break; if (_sp > XB_SPIN_CAP) { atomicAdd(&(bar)[XB_TMO], 1u); break; } } } } while (0)
struct XcdBarrier { unsigned* bar; unsigned x; volatile LAS unsigned* st; };
__device__ __forceinline__ void xcd_barrier_complete(unsigned* bar, unsigned x, unsigned& nloc, unsigned& nx, unsigned& even) {
  const unsigned G = gridDim.x * gridDim.y * gridDim.z;
  unsigned sum, cnt, mine, sp = 0u;
  for (;;) {
    sum = 0u; cnt = 0u; mine = 0u;
#pragma unroll
    for (unsigned j = 0; j < 16; ++j) { const unsigned c = xb_ld(&bar[XB_XCNT(j)]); sum += c; cnt += (c > 0u) ? 1u : 0u; mine = (j == x) ? c : mine; }
    if (sum == G) break;
    __builtin_amdgcn_s_sleep(1);
    if ((++sp & 255u) == 0u) { if (xb_ld(&bar[XB_TMO])) break; if (sp > XB_SPIN_CAP) { atomicAdd(&bar[XB_TMO], 1u); break; } }
  }
  nloc = mine > 0u ? mine : 1u; nx = cnt > 0u ? cnt : 1u;
  unsigned ev = (sum == G && cnt == 8u && (G & 7u) == 0u) ? 1u : 0u;
#pragma unroll
  for (unsigned j = 0; j < 16; ++j) { const unsigned c = xb_ld(&bar[XB_XCNT(j)]); if (c != 0u && (c != (G >> 3) || j >= 8u)) ev = 0u; }
  even = ev;
}
__device__ __forceinline__ void xcd_barrier(const XcdBarrier& b, int tid) {
  asm volatile("s_waitcnt vmcnt(0)" ::: "memory");
  __syncthreads();
  if (tid == 0) {
    unsigned* bar = b.bar;
    __builtin_amdgcn_s_waitcnt(0);
    unsigned nloc = b.st[0], nx = b.st[1];
    if (nloc == 0u) { unsigned even_ = 0u; xcd_barrier_complete(bar, b.x, nloc, nx, even_); b.st[0] = nloc; b.st[1] = nx; b.st[2] = even_; }
    const unsigned old = xb_add(&bar[XB_XSUB(b.x)], 1u);
    const unsigned gen = old / nloc;
    if (old + 1u == (gen + 1u) * nloc) {
      __builtin_amdgcn_fence(__ATOMIC_RELEASE, "agent");
      asm volatile("s_waitcnt vmcnt(0)" ::: "memory");
      const unsigned og = xb_add(&bar[XB_TOP], 1u);
      const unsigned tg = og / nx;
      if (og + 1u == (tg + 1u) * nx) xb_add(&bar[XB_TOPGEN], 1u);
      else XB_SPIN(xb_ld(&bar[XB_TOPGEN]) == tg, bar);
      __builtin_amdgcn_fence(__ATOMIC_ACQUIRE, "agent");
      xb_add(&bar[XB_XGEN(b.x)], 1u);
      asm volatile("s_waitcnt vmcnt(0)" ::: "memory");
    } else {
      XB_SPIN(xb_ld(&bar[XB_XGEN(b.x)]) == gen, bar);
      __builtin_amdgcn_fence(__ATOMIC_ACQUIRE, "agent");
      asm volatile("s_waitcnt vmcnt(0)" ::: "memory");
    }
  }
  __syncthreads();
}

__global__ void __launch_bounds__(512, 2) mega_fwd(Params kp) {
  extern __shared__ __attribute__((aligned(16))) unsigned char lds_raw[];
  LAS unsigned char* lds = (LAS unsigned char*)lds_raw;
  cg::grid_group grid = cg::this_grid();
  const int wid0 = __builtin_amdgcn_readfirstlane((int)threadIdx.x >> 6);
  int wid = wid0, lane = (int)__builtin_amdgcn_mbcnt_hi(~0u, __builtin_amdgcn_mbcnt_lo(~0u, 0u)), tid = wid * 64 + lane;
  const int G = gridDim.x, cb = blockIdx.x;
  int gw = cb * 8 + wid;
  unsigned char* ws = kp.ws;
  float* xlat = kp.out;
  DP p; p.tab = (const float* LAS*)(lds + PP_OFF); p.ws = ws;
  if (tid == 0) {
#pragma unroll
    for (int i = 0; i < 31; ++i) ((const float* LAS*)(lds + PP_OFF))[i] = kp.in[i];
    ((volatile LAS unsigned*)(lds + XB_OFF))[0] = 0u; ((volatile LAS unsigned*)(lds + XB_OFF))[1] = 0u; ((volatile LAS unsigned*)(lds + XB_OFF))[2] = 0u; ((volatile LAS unsigned*)(lds + XB_OFF))[3] = 0u;
  }
  if (cb == 0) { for (int i = tid; i < XCD_BAR_WORDS; i += 512) __hip_atomic_store((unsigned*)(ws + WS_BAR) + i, 0u, __ATOMIC_RELAXED, __HIP_MEMORY_SCOPE_AGENT); }
  __syncthreads(); float* xctx = (float*)(ws + WS_XC);
  bf16_t* hbf = (bf16_t*)(ws + WS_HBF);

  {
    const bool bgw = (G == 256);
    constexpr int N_MOD = 288, N_WF = 128, N_BY = 2, N_TB = 1073;
    const int N_WO = bgw ? 0 : 128, N_TR = bgw ? 1216 : 2 * 1216;
    const int T1 = N_WO, T2 = T1 + N_MOD, T3 = T2 + N_WF, T4 = T3 + N_BY, T5 = T4 + N_TR, T6 = T5 + N_TB;
    for (int it = cb; it < T6; it += G) {
      { unsigned z_ = 0u; asm volatile("" : "+s"(z_)); int t_ = (int)__builtin_amdgcn_mbcnt_hi(~0u, __builtin_amdgcn_mbcnt_lo(~0u, z_)); asm volatile("" : "+v"(t_)); lane = t_; wid = wid0; asm volatile("" : "+s"(wid)); tid = wid * 64 + lane; }
      if (it < T1) p0_woutfold(p, lds, it, tid, lane, wid);
      else if (it < T2) p0_mod(p, lds, it - T1, tid, lane, wid);
      else if (it < T3) p0_wfour(p, lds, it - T2, tid, lane, wid);
      else if (it < T4) p0_biasy(p, it - T3, tid);
      else if (it < T5) p0_transpose(p, lds, it - T4, tid, lane, wid);
      else p0_tables(p, it - T5, tid);
    }
  }
  grid.sync();
  XcdBarrier xbar; xbar.bar = (unsigned*)(kp.ws + WS_BAR); xbar.x = xb_xcc_id(); xbar.st = (volatile LAS unsigned*)(lds + XB_OFF);
  if (threadIdx.x == 0) xbar.st[3] = xb_add(&xbar.bar[XB_XCNT(xbar.x)], 1u);

#define RELAUNDER() do { unsigned z_ = 0u; asm volatile("" : "+s"(z_)); int t_ = (int)__builtin_amdgcn_mbcnt_hi(~0u, __builtin_amdgcn_mbcnt_lo(~0u, z_)); asm volatile("" : "+v"(t_)); \
    lane = t_; wid = wid0; asm volatile("" : "+s"(wid)); tid = wid * 64 + lane; gw = cb * 8 + wid; } while (0)
  for (int l_outer = 0; l_outer < 2; ++l_outer) {
    for (int sp = 0; sp < 12; ++sp) {
      int l = l_outer; asm volatile("" : "+s"(l));
      const bool last_layer = (l == 1);
      RELAUNDER();
      { unsigned long long w_ = (unsigned long long)kp.ws; asm volatile("" : "+s"(w_)); ws = (unsigned char*)w_; p.ws = ws; }
      const int cbv = (__builtin_amdgcn_readfirstlane((int)xbar.st[2]) != 0) ? __builtin_amdgcn_readfirstlane((int)xbar.st[3]) * 8 + (int)xbar.x : cb;
      const unsigned char* wl = ws + WS_W + (size_t)l * WL;
      const float* mod = (const float*)(ws + WS_MOD) + (size_t)l * 5 * NMOD;
      float* xctx = (float*)(ws + WS_XC); bf16_t* hbf = (bf16_t*)(ws + WS_HBF);
      bool do_gemm = false, do_sync = true;
      int K = 1024, lda = 1024, ldb = 1024;
      const pg8::Job JZ = {nullptr, nullptr, 0, 1, 0, 0, 16, 1, 0, 0};
      pg8::Job J0 = JZ, J1 = JZ, J2 = JZ, J3 = JZ; int e0 = 0, e1 = -1, e2 = -1, e3 = -1;
      const float* xin_lat = xlat; const float* xin_ctx = xctx; const float* biasy = nullptr; int gate_idx = 2; float gate_mul = 0.5f;
      const int nrt_all = 132;
      const int nrt_late = last_layer ? 128 : 132;
      if (sp == 0 || sp == 3 || sp == 9) {
        if (sp == 3 && LEVEL < 2) { do_sync = false; }
        else {
          const bool first = (l == 0 && sp == 0);
          const float* xl = first ? p.in_(I_X) : xlat;
          const float* g = p.in_(sp == 0 ? I_GF1 : (sp == 3 ? I_GMIX : I_GF2)) + l * DM;
          const int ish = sp == 0 ? 0 : (sp == 3 ? 3 : 6);
          const bool with_ctx = !(sp == 9 && last_layer);
          bf16_t* hp = (sp == 3) ? (bf16_t*)(ws + WS_REG + R_HBFP) : nullptr;
          int nc_ks = 0; const float* nc_gate = nullptr; float nc_gmul = 0.f; const float* nc_bias = nullptr; const float* xc_src = xctx;
          const float* modp = (const float*)(ws + WS_MOD);
          if (sp == 3) { nc_ks = 11; nc_gate = mod + (size_t)4 * NMOD + 2 * DM; nc_gmul = 0.5f; if (l == 0) xc_src = p.in_(I_CTX); }
          else if (sp == 9 && !last_layer) { nc_ks = 4; nc_gate = mod + (size_t)4 * NMOD + 5 * DM; nc_gmul = 1.f; nc_bias = (const float*)(ws + WS_BIASY) + l * 1024; }
          else if (sp == 0 && l == 1) { nc_ks = 11; nc_gate = modp + (size_t)4 * NMOD + 8 * DM; nc_gmul = 0.5f; }
          else if (sp == 0) { xc_src = p.in_(I_CTX); }
          norm_phase(xl, xc_src, xctx, g, mod, ish, hbf, hp, with_ctx, nc_ks, nc_gate, nc_gmul, nc_bias, ws, gw, G * 8, lane);
        }
      } else if (sp == 1 || sp == 10) {
        do_gemm = true; const int nrt = sp == 1 ? nrt_all : nrt_late;
        J0 = (pg8::Job){(const char*)hbf, (const char*)(wl + (sp == 1 ? W_FF1A : W_FF2A)), nrt, 22, K_GATEUP, 0, 16, 1, 0, 0}; e0 = nrt * 22;
      } else if (sp == 2 || sp == 11) {
        do_gemm = true; K = DFF; lda = DFF; ldb = DFF; const int nrt = sp == 2 ? nrt_all : nrt_late;
        J0 = (pg8::Job){(const char*)(ws + WS_REG + R_ACT), (const char*)(wl + (sp == 2 ? W_DN1 : W_DN2)), 128, 4, K_RES, 0, 44, 1, 0, 0}; e0 = 512;
        if (nrt > 128) { J1 = (pg8::Job){(const char*)(ws + WS_REG + R_ACT) + (size_t)NLAT * DFF * 2, (const char*)(wl + (sp == 2 ? W_DN1 : W_DN2)), 4, 4, K_RESP, 0, 4, 11, 128, 0}; e1 = e0 + 176; }
        gate_idx = sp == 2 ? 2 : 8; gate_mul = 0.5f;
        if (l == 0 && sp == 2) { xin_lat = p.in_(I_X); xin_ctx = p.in_(I_CTX); }
      } else if (LEVEL < 2) {
        do_sync = false;
      } else if (sp == 4) {
        do_gemm = true;
        J0 = (pg8::Job){(const char*)hbf, (const char*)(wl + W_INM), nrt_all, 6, K_INM, 0, 16, 1, 0, 0}; e0 = nrt_all * 6;
        J1 = (pg8::Job){(const char*)(wl + W_WV), (const char*)hbf, 2, nrt_all, K_VT, 0, 16, 1, 0, 0}; e1 = e0 + 2 * nrt_all;
        J2 = (pg8::Job){(const char*)(wl + W_WFR), (const char*)(ws + WS_REG + R_HBFP), 2, 128, K_FG, 0, 16, 1, 0, 0}; e2 = e1 + 256;
        J3 = (pg8::Job){(const char*)(wl + W_WFR), (const char*)(hbf + (size_t)NLAT * DM), 2, 4, K_FGC, 0, 16, 1, 0, 0}; e3 = e2 + (last_layer ? 0 : 8);
      } else if (sp == 5) {
        float lam;
        { const float a = wave_sum(p.in_(I_LQ1)[l * 64 + lane] * p.in_(I_LK1)[l * 64 + lane], lane), b2 = wave_sum(p.in_(I_LQ2)[l * 64 + lane] * p.in_(I_LK2)[l * 64 + lane], lane);
          const float lam_init = l == 0 ? 0.2f : 0.35550906f; lam = __expf(a) - __expf(b2) + lam_init; }
        const float oscale = l == 0 ? 0.8f : (1.f - 0.35550906f);
        const float* gsub = p.in_(I_GSUB) + l * 128;
        const int xcd = cbv & 7, cl = cbv >> 3;
        if (G == 256) {
          for (int i = 0; i < 4; ++i) { const int idx = i * 32 + cl, bh = 2 * xcd + (idx >> 6), qb = idx & 63;
            attn_unit(lds, ws, bh >> 2, bh & 3, qb * 128, 0, 132, (bh >> 2) * SEQ + qb * 128, lam, oscale, gsub, tid, lane, wid); }
        } else {
          for (int u = cbv; u < 1024; u += G) { const int bh = u >> 6, qb = u & 63;
            attn_unit(lds, ws, bh >> 2, bh & 3, qb * 128, 0, 132, (bh >> 2) * SEQ + qb * 128, lam, oscale, gsub, tid, lane, wid); }
        }
        if (!last_layer) for (int u = cbv; u < 32; u += G) { const int bh = u >> 1, qb = u & 1;
          attn_unit(lds, ws, bh >> 2, bh & 3, SEQ + qb * 128, SEQ, 4, NLAT + (bh >> 2) * CTXL + qb * 128, lam, oscale, gsub, tid, lane, wid); }
        RELAUNDER();
        if (LEVEL >= 3) { const int ncu = last_layer ? 512 : 528;
          for (int u = cbv; u < ncu; u += G) { const int row0 = u * 64; int lo, hi;
            if (row0 < NLAT) { lo = row0 & ~8191; hi = lo + SEQ; } else { lo = NLAT + ((row0 - NLAT) & ~255); hi = lo + CTXL; }
            conv_unit(lds, p, l, row0, lo, hi, tid, lane, wid); } }
        RELAUNDER();
        if (LEVEL >= 4) { do_gemm = true; K = 256; lda = 256; ldb = 256;
          J0 = (pg8::Job){(const char*)(ws + WS_DA), (const char*)(ws + WS_REG + R_GT), 1, 256, K_STA, 0, 4, 1, 0, 0}; e0 = 256; }
      } else if (sp == 6) {
        if (LEVEL >= 4) { do_gemm = true; K = 512; lda = 512; ldb = 16384; do_sync = last_layer;
          J0 = (pg8::Job){(const char*)(ws + WS_EBD), (const char*)(ws + WS_REG + R_T), 32, 4, K_STB, 1024, 8, 1, 0, 0}; e0 = 128; }
        else do_sync = false;
      } else if (sp == 7) {
        if (LEVEL >= 4 && !last_layer) { do_gemm = true; K = 512; lda = 512; ldb = 512;
          J0 = (pg8::Job){(const char*)(ws + WS_E256), (const char*)(ws + WS_REG + R_GTC), 1, 4, K_FC, 0, 8, 1, 0, 0}; e0 = 4; }
        else do_sync = false;
      } else if (sp == 8) {
        do_gemm = true;
        J0 = (pg8::Job){(const char*)(ws + WS_REG + R_CAT), (const char*)(wl + W_WOUT), 128, 4, K_RES, 0, 16, 1, 0, 0}; e0 = 512;
        if (nrt_late > 128) { J1 = (pg8::Job){(const char*)(ws + WS_REG + R_CAT) + (size_t)NLAT * DM * 2, (const char*)(wl + W_WOUT), 4, 4, K_RESP, 0, 4, 4, 128, 0}; e1 = e0 + 64; }
        gate_idx = 5; gate_mul = 1.f; biasy = (const float*)(ws + WS_BIASY) + l * 1024;
      }
      if (do_gemm) {
        LAS pg8::PhaseDesc* pd = (LAS pg8::PhaseDesc*)(lds + PD_OFF);
        if (e1 < 0) e1 = e0; if (e2 < 0) e2 = e1; if (e3 < 0) e3 = e2;
        __syncthreads();
        if (tid == 0) {
#define PUTJ(i, J) do { pd->j[i].A = J.A; pd->j[i].B = J.B; pd->j[i].nM = J.nM; pd->j[i].nN = J.nN; pd->j[i].kind = J.kind; pd->j[i].kshift = J.kshift; pd->j[i].nt = J.nt; pd->j[i].ksplit = J.ksplit; pd->j[i].pmoff = J.pmoff; } while (0)
          PUTJ(0, J0); PUTJ(1, J1); PUTJ(2, J2); PUTJ(3, J3);
#undef PUTJ
          pd->e[0] = e0; pd->e[1] = e1; pd->e[2] = e2; pd->e[3] = e3;
          pd->xin_lat = xin_lat; pd->xin_ctx = xin_ctx; pd->xout_lat = xlat; pd->xout_ctx = xctx; pd->mod = mod; pd->biasy = biasy; pd->gate_idx = gate_idx; pd->gate_mul = gate_mul; }
        __syncthreads();
        pg8::Sched S; S.pd = pd; S.G = G; S.c = cbv; S.tsA = (size_t)256 * lda * 2; S.tsB = (size_t)256 * ldb * 2;
        Epi E; E.ws = ws; E.pd = pd;
        pg8::gemm_phase<Epi>(lds, tid, lda, ldb, S, E);
        if (G == 256 && l == 0 && (sp == 1 || sp == 4 || sp == 10)) {
          const int first_idle = (sp == 4) ? 40 : 88;
          const int nfold = (sp == 10) ? 0 : 64;
          const int tbase = (sp == 1) ? 0 : (sp == 4 ? 312 : 768);
          const int ci = cbv - first_idle;
          if (ci >= 0) {
            for (int j = 0; j < 3; ++j) {
              RELAUNDER();
              if (ci < nfold) { if (j == 0) p0_woutfold(p, lds, (sp == 1 ? 0 : 64) + ci, tid, lane, wid); }
              else { const int idx = tbase + (ci - nfold) * 3 + j; if (idx < 1216) p0_transpose(p, lds, 1216 + idx, tid, lane, wid); }
            }
          }
        }
      }
      if (do_sync) xcd_barrier(xbar, tid);
    }
  }
  {
    const float* g = p.in_(I_GFIN);
    f32x4 gv[4];
#pragma unroll
    for (int j = 0; j < 4; ++j) gv[j] = *(const f32x4*)(g + 4 * lane + 256 * j);
    for (int r = gw; r < NLAT; r += G * 8) {
      float* xr = xlat + (size_t)r * DM; f32x4 v[4]; float ss = 0.f;
#pragma unroll
      for (int j = 0; j < 4; ++j) { v[j] = *(const f32x4*)(xr + 4 * lane + 256 * j); ss += (v[j][0] * v[j][0] + v[j][1] * v[j][1]) + (v[j][2] * v[j][2] + v[j][3] * v[j][3]); }
      const float rstd = 1.0f / sqrtf(wave_sum(ss, lane) * (1.f / DM) + EPS);
#pragma unroll
      for (int j = 0; j < 4; ++j) *(f32x4*)(xr + 4 * lane + 256 * j) = v[j] * rstd * gv[j];
    }
  }
}

extern "C" void kernel_launch(void* const* d_in, const int* in_sizes, int n_in, void* d_out, int out_size, void* d_ws, size_t ws_size, hipStream_t stream) {
  static int grid = 0;
  if (grid == 0) {
    if (n_in != 31 || out_size != NLAT * DM || ws_size < WS_END) { fprintf(stderr, "kernel_launch: unexpected shapes (n_in %d out %d ws %zu need %zu)\n", n_in, out_size, ws_size, (size_t)WS_END); grid = -1; return; }
    int dev = 0, cus = 0, per_cu = 0;
    hipGetDevice(&dev); hipDeviceGetAttribute(&cus, hipDeviceAttributeMultiprocessorCount, dev);
    hipFuncSetAttribute((const void*)mega_fwd, hipFuncAttributeMaxDynamicSharedMemorySize, LDS_BYTES);
    hipOccupancyMaxActiveBlocksPerMultiprocessor(&per_cu, (const void*)mega_fwd, 512, LDS_BYTES);
    if (per_cu < 1) { fprintf(stderr, "kernel_launch: occupancy query says %d blocks/CU\n", per_cu); per_cu = 1; }
    (void)hipGetLastError();
    grid = cus * 1;
  }
  if (grid < 0) return;
  Params p{};
  for (int i = 0; i < 31; ++i) p.in[i] = (const float*)d_in[i];
  p.out = (float*)d_out; p.ws = (unsigned char*)d_ws;
  void* args[] = {&p};
  hipError_t e = hipLaunchCooperativeKernel((const void*)mega_fwd, dim3(grid), dim3(512), args, LDS_BYTES, stream);
  if (e != hipSuccess) fprintf(stderr, "cooperative launch failed: %s (grid %d)\n", hipGetErrorString(e), grid);
}
```

```cpp
#include <hip/hip_runtime.h>
#include <hip/hip_cooperative_groups.h>
#include <cstdio>
#include <cstdint>
namespace cg = cooperative_groups;

#ifndef LEVEL
#define LEVEL 9
#endif

#define LAS __attribute__((address_space(3)))
typedef unsigned short bf16_t;
typedef short bf16x8 __attribute__((ext_vector_type(8)));
typedef float f32x4 __attribute__((ext_vector_type(4)));
typedef float f32x2 __attribute__((ext_vector_type(2)));
typedef float f32x16 __attribute__((ext_vector_type(16)));
typedef unsigned u32x4 __attribute__((ext_vector_type(4)));
typedef unsigned u32x2 __attribute__((ext_vector_type(2)));
typedef __bf16 bf16x2_t __attribute__((ext_vector_type(2)));

constexpr int DM = 1024, NB = 4, SEQ = 8192, CTXL = 256, NLAT = NB * SEQ, NCTX = NB * CTXL, MROWS = NLAT + NCTX;
constexpr int DFF = 2816, NKV = SEQ + CTXL, NMOD = 9 * DM;
constexpr float EPS = 1e-6f;
constexpr float LOG2E = 1.4426950408889634f;
constexpr float QSCALE = 0.125f * LOG2E;

constexpr size_t WS_BAR = 0;
constexpr size_t WS_MOD = 16384;
constexpr size_t WS_BIASY = WS_MOD + 2 * 5 * NMOD * 4;
constexpr size_t WS_ROPE = WS_BIASY + 2 * 1024 * 4;
constexpr size_t WS_DA = WS_ROPE + 129 * 16 * 8 + 128;
constexpr size_t WS_E256 = WS_DA + 256 * 256 * 2;
constexpr size_t WS_EBD = WS_E256 + 256 * 512 * 2;
constexpr size_t WS_XC = WS_EBD + (size_t)8192 * 512 * 2;
constexpr size_t WS_W = WS_XC + (size_t)NCTX * DM * 4;
constexpr size_t W_FF1A = 0, W_DN1 = W_FF1A + (size_t)5632 * 1024 * 2, W_FF2A = W_DN1 + (size_t)1024 * 2816 * 2,
                 W_DN2 = W_FF2A + (size_t)5632 * 1024 * 2, W_INM = W_DN2 + (size_t)1024 * 2816 * 2, W_WV = W_INM + (size_t)1536 * 1024 * 2,
                 W_WFR = W_WV + (size_t)512 * 1024 * 2, W_WOUT = W_WFR + (size_t)512 * 1024 * 2, WL = W_WOUT + (size_t)1024 * 1024 * 2;
constexpr size_t WS_HBF = WS_W + 2 * WL;
constexpr size_t WS_REG = WS_HBF + (size_t)MROWS * DM * 2;
constexpr size_t R_ACT = 0;
constexpr size_t R_QS = 0, R_KS = R_QS + (size_t)32 * NKV * 64 * 2, R_VT = R_KS + (size_t)32 * NKV * 64 * 2,
                 R_YGLU = R_VT + (size_t)16 * 128 * NKV * 2, R_GT = R_YGLU + (size_t)MROWS * 256 * 2, R_HBFP = R_GT + (size_t)65536 * 256 * 2,
                 R_T = R_HBFP, R_GTC = R_HBFP + (size_t)NLAT * DM * 2, R_CAT = R_GTC + (size_t)1024 * 512 * 2, R_END = R_CAT + (size_t)MROWS * DM * 2;
constexpr size_t WS_PART = WS_REG + (R_END > (size_t)MROWS * DFF * 2 ? R_END : (size_t)MROWS * DFF * 2);
constexpr size_t WS_END = WS_PART + (size_t)11 * NCTX * DM * 4;
static_assert(WS_W % 256 == 0 && WS_HBF % 256 == 0 && WS_REG % 256 == 0 && WS_EBD % 256 == 0 && WS_DA % 256 == 0, "align");

constexpr int LDS_BYTES = 147456, PD_OFF = 131072 + 1024, PP_OFF = PD_OFF + 512, XB_OFF = PP_OFF + 512;

__device__ __forceinline__ unsigned cvtpk(float lo, float hi) { f32x2 v = {lo, hi}; bf16x2_t b = __builtin_convertvector(v, bf16x2_t); return __builtin_bit_cast(unsigned, b); }
__device__ __forceinline__ float bf2f(unsigned v16) { return __uint_as_float(v16 << 16); }
__device__ __forceinline__ float shx(float v, int o, int lane) { return __int_as_float(__builtin_amdgcn_ds_bpermute((lane ^ o) << 2, __float_as_int(v))); }
__device__ __forceinline__ float wave_sum(float v, int lane) {
#pragma unroll
  for (int o = 1; o < 64; o <<= 1) v += shx(v, o, lane);
  return v;
}
__device__ __forceinline__ float sigmoid_f(float x) { return __builtin_amdgcn_rcpf(1.f + __builtin_amdgcn_exp2f(-LOG2E * x)); }
__device__ __forceinline__ float silu_f(float x) { return x * sigmoid_f(x); }
__device__ __forceinline__ u32x4 pack8(const f32x4 a, const f32x4 b) { u32x4 w; w.x = cvtpk(a[0], a[1]); w.y = cvtpk(a[2], a[3]); w.z = cvtpk(b[0], b[1]); w.w = cvtpk(b[2], b[3]); return w; }

namespace pg8 {
constexpr int BM = 256, BK = 64, HALF = 128, HTB = HALF * BK * 2, STAGE_BYTES = 8 * HTB;
__device__ __forceinline__ int lds_byte(int r, int c) { const int st = (r >> 4) * 2 + (c >> 5), rr = r & 15, cc = c & 31, ob = rr * 64 + cc * 2; return st * 1024 + (ob ^ (((ob >> 9) & 1) << 5)); }
__device__ __forceinline__ void stage_rc(int b, int& R, int& C) { const int st = b / 1024, sb = b % 1024, swz = sb ^ (((sb >> 9) & 1) << 5); R = (st >> 1) * 16 + swz / 64; C = (st & 1) * 32 + (swz % 64) / 2; }
__device__ __forceinline__ int perm32(int rho) { const int n = rho >> 4, i = rho & 15; return 8 * (i >> 2) + 4 * n + (i & 3); }

struct Unit { const char* A; const char* B; int pm, pn, kind, nt, kc; };
struct Job { const char* A; const char* B; int nM, nN, kind, kshift, nt, ksplit, pmoff, pad_; };
struct PhaseDesc {
  Job j[4]; int e[4];
  const float* xin_lat; const float* xin_ctx; float* xout_lat; float* xout_ctx; const float* mod; const float* biasy; int gate_idx; float gate_mul;
};
__device__ __forceinline__ int rfl(int v) { return __builtin_amdgcn_readfirstlane(v); }
__device__ __forceinline__ const char* rflp(const char* p) { const unsigned long long u = (unsigned long long)p; const unsigned lo = (unsigned)rfl((int)(unsigned)u), hi = (unsigned)rfl((int)(unsigned)(u >> 32)); return (const char*)(((unsigned long long)hi << 32) | lo); }
struct Sched {
  const LAS PhaseDesc* pd; int G, c; size_t tsA, tsB;
  __device__ __forceinline__ bool next(int i, Unit& u) const {
    const long L = (long)i * G + c; const int e0 = rfl(pd->e[0]), e1 = rfl(pd->e[1]), e2 = rfl(pd->e[2]), e3 = rfl(pd->e[3]);
    if (L >= e3) return false;
    int ji, Ll;
    if (L < e0) { ji = 0; Ll = (int)L; } else if (L < e1) { ji = 1; Ll = (int)L - e0; } else if (L < e2) { ji = 2; Ll = (int)L - e1; } else { ji = 3; Ll = (int)L - e2; }
    const LAS Job* J = &pd->j[ji];
    const int nM = rfl(J->nM), nN = rfl(J->nN), kshift = rfl(J->kshift), ksplit = rfl(J->ksplit), jnt = rfl(J->nt);
    const int nwg = nM * nN * ksplit, q = nwg / 8, r = nwg % 8, xcd = Ll % 8, off = Ll / 8;
    const int w0 = (xcd < r ? xcd * (q + 1) : r * (q + 1) + (xcd - r) * q) + off;
    const int kc = w0 % ksplit, w = w0 / ksplit;
    const int nig = 8 * nN, gid = w / nig, fm = gid * 8, gsz = (nM - fm) < 8 ? (nM - fm) : 8;
    const int pm = fm + ((w % nig) % gsz);
    u.pm = pm + rfl(J->pmoff); u.pn = (w % nig) / gsz; u.kind = rfl(J->kind); u.nt = jnt; u.kc = kc;
    u.A = rflp(J->A) + (size_t)pm * tsA + (size_t)kc * jnt * 128; u.B = rflp(J->B) + (size_t)u.pn * tsB + (size_t)pm * (size_t)kshift + (size_t)kc * jnt * 128;
    return true;
  }
};

template <class Epi>
__device__ __forceinline__ void gemm_phase(LAS unsigned char* lds, const int tid, const int lda, const int ldb, const Sched& S, const Epi& E) {
  const int wid = __builtin_amdgcn_readfirstlane(tid >> 6), lane = tid & 63, wr = wid >> 2, wc = wid & 3, fr = lane & 15, fq = lane >> 4;
  unsigned voffA[2], voffB[2];
#pragma unroll
  for (int i = 0; i < 2; ++i) { int R, C; stage_rc(tid * 16 + i * 8192, R, C); const int Rb = (R & ~31) + perm32(R & 31);
    voffA[i] = (unsigned)(R * lda + C) * 2u; voffB[i] = (unsigned)(Rb * ldb + C) * 2u; }
  const size_t kstep = (size_t)(BK * 2);
  const size_t hstepA = (size_t)HALF * lda * 2, hstepB = (size_t)HALF * ldb * 2;
  const unsigned ldsw = (unsigned)wid * 1024u;
  const int aoff = lds_byte(wr * 64 + fr, fq * 8), boff = lds_byte(wc * 32 + fr, fq * 8);
#define PG8_SA(b, h) (((b) * 2 + (h)) * HTB)
#define PG8_SB(b, h) ((4 + (b) * 2 + (h)) * HTB)
#define PG8_STAGE(bufoff, gbase, voff) do { _Pragma("unroll") for (int _i = 0; _i < 2; ++_i) \
    __builtin_amdgcn_global_load_lds((const unsigned*)((const char*)(gbase) + (voff)[_i]), (LAS unsigned*)(lds + (bufoff) + ldsw + _i * 8192), 16, 0, 0); } while (0)
#define PG8_LDA(dst, b, h) do { _Pragma("unroll") for (int m = 0; m < 4; ++m) _Pragma("unroll") for (int k = 0; k < 2; ++k) dst[m][k] = *(const LAS bf16x8*)(lds + PG8_SA(b, h) + aoff + m * 2048 + k * 1024); } while (0)
#define PG8_LDB(dst, b, h) do { _Pragma("unroll") for (int n = 0; n < 2; ++n) _Pragma("unroll") for (int k = 0; k < 2; ++k) dst[n][k] = *(const LAS bf16x8*)(lds + PG8_SB(b, h) + boff + n * 2048 + k * 1024); } while (0)
#define PG8_MMA(ai, bj, At, Bt) do { __builtin_amdgcn_s_setprio(1); _Pragma("unroll") for (int m = 0; m < 4; ++m) _Pragma("unroll") for (int n = 0; n < 2; ++n) _Pragma("unroll") for (int k = 0; k < 2; ++k) \
    acc[ai][bj][m][n] = __builtin_amdgcn_mfma_f32_16x16x32_bf16(Bt[n][k], At[m][k], acc[ai][bj][m][n], 0, 0, 0); __builtin_amdgcn_s_setprio(0); } while (0)
#define PG8_WAIT_V(n) asm volatile("s_waitcnt vmcnt(" #n ")" ::: "memory")
#define PG8_WAIT_L(n) asm volatile("s_waitcnt lgkmcnt(" #n ")" ::: "memory")
#define PG8_BAR __builtin_amdgcn_s_barrier()
#define PG8_SCHED __builtin_amdgcn_sched_barrier(0)
  Unit cur, nxt; int ui = 0;
  if (!S.next(0, cur)) return;
  f32x4 acc[2][2][4][2];
#pragma unroll
  for (int a = 0; a < 2; ++a)
#pragma unroll
    for (int b = 0; b < 2; ++b)
#pragma unroll
      for (int m = 0; m < 4; ++m)
#pragma unroll
        for (int n = 0; n < 2; ++n) acc[a][b][m][n] = (f32x4){0.f, 0.f, 0.f, 0.f};
  bf16x8 At[4][2], B0[2][2], B1[2][2];
  const char* cA = cur.A; const char* cB = cur.B;
  PG8_STAGE(PG8_SB(0, 0), cB, voffB); PG8_STAGE(PG8_SB(0, 1), cB + hstepB, voffB); PG8_STAGE(PG8_SA(0, 0), cA, voffA); PG8_STAGE(PG8_SA(0, 1), cA + hstepA, voffA);
  if (wr == 1) PG8_BAR;
  PG8_WAIT_V(2); PG8_BAR;
  PG8_STAGE(PG8_SB(1, 0), cB + kstep, voffB); PG8_STAGE(PG8_SA(1, 0), cA + kstep, voffA); PG8_STAGE(PG8_SB(1, 1), cB + hstepB + kstep, voffB);
  PG8_WAIT_V(6); PG8_BAR;
  for (;;) {
    const bool has_next = S.next(ui + 1, nxt);
    const char* nA = has_next ? nxt.A : cA; const char* nB = has_next ? nxt.B : cB;
    const int nt = cur.nt;
    for (int t = 0; t < nt; t += 2) {
      const bool last = (t == nt - 2);
      const char* a1 = cA + (size_t)(t + 1) * kstep;
      const char* a2 = last ? nA : cA + (size_t)(t + 2) * kstep; const char* b2 = last ? nB : cB + (size_t)(t + 2) * kstep;
      const char* a3 = a2 + kstep; const char* b3 = b2 + kstep;
      PG8_LDB(B0, 0, 0); PG8_LDB(B1, 0, 1); PG8_SCHED; PG8_LDA(At, 0, 0); PG8_STAGE(PG8_SA(1, 1), a1 + hstepA, voffA);
      PG8_WAIT_V(8); PG8_WAIT_L(0); PG8_BAR; PG8_MMA(0, 0, At, B0); PG8_MMA(0, 1, At, B1); PG8_BAR; PG8_SCHED;
      PG8_LDA(At, 0, 1); PG8_STAGE(PG8_SB(0, 0), b2, voffB); PG8_STAGE(PG8_SB(0, 1), b2 + hstepB, voffB); PG8_STAGE(PG8_SA(0, 0), a2, voffA);
      PG8_WAIT_V(8); PG8_WAIT_L(0); PG8_BAR; PG8_MMA(1, 0, At, B0); PG8_MMA(1, 1, At, B1); PG8_BAR; PG8_SCHED;
      PG8_LDB(B0, 1, 0); PG8_LDB(B1, 1, 1); PG8_SCHED; PG8_LDA(At, 1, 0); PG8_STAGE(PG8_SA(0, 1), a2 + hstepA, voffA);
      PG8_WAIT_V(8); PG8_WAIT_L(0); PG8_BAR; PG8_MMA(0, 0, At, B0); PG8_MMA(0, 1, At, B1); PG8_BAR; PG8_SCHED;
      PG8_LDA(At, 1, 1); PG8_STAGE(PG8_SB(1, 0), b3, voffB); PG8_STAGE(PG8_SB(1, 1), b3 + hstepB, voffB); PG8_STAGE(PG8_SA(1, 0), a3, voffA);
      PG8_WAIT_V(8); PG8_WAIT_L(0); PG8_BAR; PG8_MMA(1, 0, At, B0); PG8_MMA(1, 1, At, B1); PG8_BAR; PG8_SCHED;
    }
    if (wr == 0) PG8_BAR;
    { int fr_ = fr, fq_ = fq, wr_ = wr, wc_ = wc; asm volatile("" : "+v"(fr_), "+v"(fq_), "+s"(wr_), "+s"(wc_));
      E(acc, cur, wr_, wc_, fr_, fq_); }
    if (!has_next) break;
#pragma unroll
    for (int a = 0; a < 2; ++a)
#pragma unroll
      for (int b = 0; b < 2; ++b)
#pragma unroll
        for (int m = 0; m < 4; ++m)
#pragma unroll
          for (int n = 0; n < 2; ++n) acc[a][b][m][n] = (f32x4){0.f, 0.f, 0.f, 0.f};
    cur = nxt; cA = nA; cB = nB; ++ui;
    if (wr == 1) PG8_BAR;
  }
  PG8_WAIT_V(0);
  PG8_BAR;
#undef PG8_SA
#undef PG8_SB
#undef PG8_STAGE
#undef PG8_LDA
#undef PG8_LDB
#undef PG8_MMA
#undef PG8_WAIT_V
#undef PG8_WAIT_L
#undef PG8_BAR
#undef PG8_SCHED
}
}

enum Kind { K_GATEUP = 0, K_RES = 1, K_INM = 2, K_VT = 3, K_FG = 4, K_FGC = 5, K_STA = 6, K_STB = 7, K_FC = 8, K_RESP = 9 };

struct Epi {
  unsigned char* ws;
  const LAS pg8::PhaseDesc* pd;
  __device__ __forceinline__ void operator()(f32x4 (&acc)[2][2][4][2], const pg8::Unit& u, int wr, int wc, int fr, int fq) const {
    const int kind = u.kind, pm = u.pm, pn = u.pn;
    const unsigned rlane = (unsigned)(wr * 64 + fr);
    const unsigned clane = (unsigned)(wc * 32 + fq * 8);
    if (kind == K_GATEUP) {
      char* act = (char*)(ws + WS_REG + R_ACT) + ((size_t)pm * 256 * DFF + (size_t)pn * 128) * 2;
      const unsigned vo = (rlane * DFF + clane) * 2u;
#pragma unroll
      for (int ai = 0; ai < 2; ++ai)
#pragma unroll
        for (int m = 0; m < 4; ++m) {
          f32x4 v0, v1;
#pragma unroll
          for (int e = 0; e < 4; ++e) { v0[e] = silu_f(acc[ai][0][m][0][e]) * acc[ai][1][m][0][e]; v1[e] = silu_f(acc[ai][0][m][1][e]) * acc[ai][1][m][1][e]; }
          *(u32x4*)(act + (vo + (unsigned)((ai * 128 + m * 16) * DFF * 2))) = pack8(v0, v1);
        }
    } else if (kind == K_RES) {
      const int mr = pm < 128 ? (pm >> 5) : 4;
      const float gate_mul = __int_as_float(pg8::rfl(__float_as_int(pd->gate_mul)));
      const char* gate = (const char*)((const float*)pg8::rflp((const char*)pd->mod) + (size_t)mr * NMOD + pg8::rfl(pd->gate_idx) * DM + pn * 256);
      const char* biasy = pg8::rflp((const char*)pd->biasy); const bool hasb = biasy != nullptr; if (hasb) biasy += (size_t)pn * 256 * 4;
      const char* xi = (const char*)(pm < 128 ? (const float*)pg8::rflp((const char*)pd->xin_lat) + (size_t)pm * 256 * DM : (const float*)pg8::rflp((const char*)pd->xin_ctx) + (size_t)(pm - 128) * 256 * DM) + (size_t)pn * 256 * 4;
      char* xo = (char*)(pm < 128 ? (float*)pg8::rflp((const char*)pd->xout_lat) + (size_t)pm * 256 * DM : (float*)pg8::rflp((const char*)pd->xout_ctx) + (size_t)(pm - 128) * 256 * DM) + (size_t)pn * 256 * 4;
      const unsigned vo = (rlane * DM + clane) * 4u, vc = clane * 4u;
      f32x4 gv[2][2], gb[2][2];
#pragma unroll
      for (int bj = 0; bj < 2; ++bj)
#pragma unroll
        for (int n = 0; n < 2; ++n) { const unsigned oc = vc + (unsigned)(bj * 512 + n * 16);
          gv[bj][n] = *(const f32x4*)(gate + oc) * gate_mul;
          gb[bj][n] = hasb ? gv[bj][n] * *(const f32x4*)(biasy + oc) : (f32x4){0.f, 0.f, 0.f, 0.f}; }
      f32x4 xa_[2][2], xb_[2][2];
#define RES_LD(BUF, g) do { _Pragma("unroll") for (int bj = 0; bj < 2; ++bj) _Pragma("unroll") for (int n = 0; n < 2; ++n) \
        BUF[bj][n] = *(const f32x4*)(xi + (vo + (unsigned)((((g) >> 2) * 128 + ((g) & 3) * 16) * DM * 4 + bj * 512 + n * 16))); } while (0)
#define RES_ST(BUF, g) do { _Pragma("unroll") for (int bj = 0; bj < 2; ++bj) _Pragma("unroll") for (int n = 0; n < 2; ++n) \
        *(f32x4*)(xo + (vo + (unsigned)((((g) >> 2) * 128 + ((g) & 3) * 16) * DM * 4 + bj * 512 + n * 16))) = BUF[bj][n] + gb[bj][n] + gv[bj][n] * acc[(g) >> 2][bj][(g) & 3][n]; \
        asm volatile("" ::: "memory"); } while (0)
      RES_LD(xa_, 0); RES_LD(xb_, 1); asm volatile("" ::: "memory");
      RES_ST(xa_, 0); RES_LD(xa_, 2); asm volatile("" ::: "memory");
      RES_ST(xb_, 1); RES_LD(xb_, 3); asm volatile("" ::: "memory");
      RES_ST(xa_, 2); RES_LD(xa_, 4); asm volatile("" ::: "memory");
      RES_ST(xb_, 3); RES_LD(xb_, 5); asm volatile("" ::: "memory");
      RES_ST(xa_, 4); RES_LD(xa_, 6); asm volatile("" ::: "memory");
      RES_ST(xb_, 5); RES_LD(xb_, 7); asm volatile("" ::: "memory");
      RES_ST(xa_, 6);
      RES_ST(xb_, 7);
#undef RES_LD
#undef RES_ST
    } else if (kind == K_RESP) {
      char* part = (char*)(ws + WS_PART) + ((size_t)u.kc * NCTX * DM + (size_t)(pm - 128) * 256 * DM + (size_t)pn * 256) * 4;
      const unsigned vo = (rlane * DM + clane) * 4u;
#pragma unroll
      for (int ai = 0; ai < 2; ++ai)
#pragma unroll
        for (int m = 0; m < 4; ++m) {
#pragma unroll
          for (int bj = 0; bj < 2; ++bj)
#pragma unroll
            for (int n = 0; n < 2; ++n) *(f32x4*)(part + (vo + (unsigned)((ai * 128 + m * 16) * DM * 4 + bj * 512 + n * 16))) = acc[ai][bj][m][n];
          asm volatile("" ::: "memory");
        }
    } else if (kind == K_INM) {
      const bool lat = pm < 128; const int b = lat ? (pm >> 5) : pm - 128;
      if (pn < 4) {
        const bool isK = pn >= 2; const int pt = pn & 1;
        const int nbase = lat ? (pm & 31) * 256 : SEQ;
        char* dst0 = (char*)(ws + WS_REG + (isK ? R_KS : R_QS)) + (((size_t)((b * 4 + 2 * pt) * 2)) * NKV + nbase) * 128;
        const char* rope = (const char*)(ws + WS_ROPE);
        const float sc = isK ? 1.f : QSCALE;
        const unsigned isub = (unsigned)(wc >> 1), colrot = (unsigned)(wc & 1);
        const unsigned vo = ((isub * NKV + rlane) * 64u + 32u * colrot + 8u * (unsigned)fq) * 2u;
#pragma unroll
        for (int ai = 0; ai < 2; ++ai) {
          f32x4 t0[4], t1[4];
#pragma unroll
          for (int m = 0; m < 4; ++m) {
            const unsigned npos = (unsigned)nbase + rlane + (unsigned)(ai * 128 + m * 16);
            const unsigned pos = lat ? (colrot ? (npos & 63u) : (npos >> 6)) : 128u;
            t0[m] = *(const f32x4*)(rope + (pos * 16u + 4u * (unsigned)fq) * 8u); t1[m] = *(const f32x4*)(rope + (pos * 16u + 4u * (unsigned)fq + 2u) * 8u); }
#pragma unroll
          for (int m = 0; m < 4; ++m) {
#pragma unroll
            for (int bj = 0; bj < 2; ++bj) {
              const f32x4 a0 = acc[ai][bj][m][0], a1 = acc[ai][bj][m][1];
              f32x4 v0, v1;
              v0[0] = (a0[0] * t0[m][0] - a0[1] * t0[m][1]) * sc; v0[1] = (a0[1] * t0[m][0] + a0[0] * t0[m][1]) * sc;
              v0[2] = (a0[2] * t0[m][2] - a0[3] * t0[m][3]) * sc; v0[3] = (a0[3] * t0[m][2] + a0[2] * t0[m][3]) * sc;
              v1[0] = (a1[0] * t1[m][0] - a1[1] * t1[m][1]) * sc; v1[1] = (a1[1] * t1[m][0] + a1[0] * t1[m][1]) * sc;
              v1[2] = (a1[2] * t1[m][2] - a1[3] * t1[m][3]) * sc; v1[3] = (a1[3] * t1[m][2] + a1[2] * t1[m][3]) * sc;
              *(u32x4*)(dst0 + (vo + (unsigned)((ai * 128 + m * 16) * 128) + (unsigned)bj * (unsigned)(2 * NKV * 128))) = pack8(v0, v1);
            } }
          asm volatile("" ::: "memory");
        }
      } else {
        char* yg = (char*)(ws + WS_REG + R_YGLU) + ((size_t)pm * 256 * 256 + (size_t)(pn - 4) * 128) * 2;
        const unsigned vo = (rlane * 256u + clane) * 2u;
#pragma unroll
        for (int ai = 0; ai < 2; ++ai)
#pragma unroll
          for (int m = 0; m < 4; ++m) {
            f32x4 v0, v1;
#pragma unroll
            for (int e = 0; e < 4; ++e) { v0[e] = acc[ai][0][m][0][e] * sigmoid_f(acc[ai][1][m][0][e]); v1[e] = acc[ai][0][m][1][e] * sigmoid_f(acc[ai][1][m][1][e]); }
            *(u32x4*)(yg + (vo + (unsigned)((ai * 128 + m * 16) * 512))) = pack8(v0, v1);
          }
      }
    } else {
      size_t ub; unsigned vl, sA, sM, sB; size_t roff;
      if (kind == K_VT) {
        const int b = pn < 128 ? (pn >> 5) : pn - 128, n0 = pn < 128 ? (pn & 31) * 256 : SEQ;
        roff = R_VT; ub = (((size_t)((b * 4 + 2 * pm) * 128)) * NKV + n0) * 2; vl = (rlane * NKV + (unsigned)(wc * 32 + (fq >> 1) * 16 + 4 * (fq & 1))) * 2u; sA = 128u * NKV * 2u; sM = 16u * NKV * 2u; sB = 256u;
      } else if (kind == K_FG) {
        const int b = pn >> 5;
        roff = R_GT; ub = ((size_t)(((b * 4 + 2 * pm) * 64) * 64 + 2 * (pn & 31))) * 512; vl = ((unsigned)fr * 64u * 256u + (unsigned)wr * 128u + clane) * 2u; sA = 64u * 64u * 256u * 2u; sM = 16u * 64u * 256u * 2u; sB = 512u;
      } else if (kind == K_FGC) {
        roff = R_GTC; ub = ((size_t)((pn * 4 + 2 * pm) * 64)) * 1024; vl = ((unsigned)fr * 512u + (unsigned)wr * 256u + clane) * 2u; sA = 64u * 512u * 2u; sM = 16u * 512u * 2u; sB = 256u;
      } else if (kind == K_STA) {
        roff = R_T; ub = ((size_t)(4 * pn * 128 * 2)) * 128; vl = ((((unsigned)(wc >> 1) * 128u + rlane) * 2u) * 64u + (unsigned)(wc & 1) * 32u + (unsigned)fq * 8u) * 2u; sA = 128u; sM = 16u * 2u * 64u * 2u; sB = 2u * 128u * 2u * 64u * 2u;
      } else if (kind == K_STB) {
        roff = R_CAT; ub = (((size_t)(pn * SEQ + 4 * pm)) * DM + 768) * 2; vl = (((unsigned)wr + 128u * (unsigned)fr) * DM + clane) * 2u; sA = 2u * DM * 2u; sM = 128u * 16u * DM * 2u; sB = 256u;
      } else {
        roff = R_CAT; ub = (((size_t)(NLAT + pn * CTXL)) * DM + 768) * 2; vl = (rlane * DM + clane) * 2u; sA = 128u * DM * 2u; sM = 16u * DM * 2u; sB = 256u;
      }
      char* dst0 = (char*)(ws + WS_REG + roff) + ub;
#pragma unroll
      for (int ai = 0; ai < 2; ++ai)
#pragma unroll
        for (int m = 0; m < 4; ++m) {
#pragma unroll
          for (int bj = 0; bj < 2; ++bj) {
            const u32x4 w = pack8(acc[ai][bj][m][0], acc[ai][bj][m][1]);
            char* d_ = dst0 + (vl + (unsigned)ai * sA + (unsigned)m * sM + (unsigned)bj * sB);
            if (kind == K_VT) { *(u32x2*)d_ = (u32x2){w.x, w.y}; *(u32x2*)(d_ + 16) = (u32x2){w.z, w.w}; }
            else *(u32x4*)d_ = w;
          }
          asm volatile("" ::: "memory");
        }
    }
  }
};

struct Params { const float* in[31]; float* out; unsigned char* ws; };
struct DP {
  const float* LAS* tab; unsigned char* ws;
  __device__ __forceinline__ const float* in_(int i) const { return (const float*)pg8::rflp((const char*)tab[i]); }
};
enum { I_X = 0, I_C, I_CTX, I_CCTX, I_WADA, I_BADA, I_GF1, I_GMIX, I_GF2, I_W1G, I_W1U, I_W1D, I_W2G, I_W2U, I_W2D, I_WIN, I_LQ1, I_LK1, I_LQ2, I_LK2,
       I_GSUB, I_WDW, I_BDW, I_GCLN, I_BCLN, I_WPW, I_BPW, I_WF, I_BF, I_WOUT, I_GFIN };

__device__ __forceinline__ int dperm(int p) { const int pi = p >> 1, w = p & 1; return pi < 16 ? pi + 16 * w : 32 + (pi - 16) + 16 * w; }

__device__ __forceinline__ void p0_transpose(const DP& p, LAS unsigned char* lds, int it, int tid, int lane, int wid) {
  const int l = it / 1216; int r = it % 1216;
  unsigned char* wl = p.ws + WS_W + (size_t)l * WL;
  const float* src; int srcld, scol, n0, k0, dstld; bf16_t* dst;
  if (r < 352 || (r >= 528 && r < 880)) {
    const bool second = r >= 528; if (second) r -= 528;
    n0 = (r / 4) * 64; k0 = (r % 4) * 256; const int n = n0 + lane; const int half = (n >> 7) & 1;
    const float* wg = p.in_(second ? I_W2G : I_W1G) + (size_t)l * 1024 * DFF; const float* wu = p.in_(second ? I_W2U : I_W1U) + (size_t)l * 1024 * DFF;
    src = half ? wu : wg; srcld = DFF; scol = (n >> 8) * 128 + (n & 127); dst = (bf16_t*)(wl + (second ? W_FF2A : W_FF1A)); dstld = 1024;
  } else if (r < 528 || (r >= 880 && r < 1056)) {
    const bool second = r >= 880; r -= second ? 880 : 352;
    n0 = (r / 11) * 64; k0 = (r % 11) * 256; src = p.in_(second ? I_W2D : I_W1D) + (size_t)l * DFF * 1024; srcld = 1024; scol = n0 + lane;
    dst = (bf16_t*)(wl + (second ? W_DN2 : W_DN1)); dstld = DFF;
  } else if (r < 1152) {
    r -= 1056; n0 = (r / 4) * 64; k0 = (r % 4) * 256; const int n = n0 + lane; src = p.in_(I_WIN) + (size_t)l * 1024 * 2304; srcld = 2304;
    if (n < 1024) scol = (n & ~63) + dperm(n & 63); else { const int nn = n - 1024; scol = 1536 + ((nn >> 7) & 1) * 256 + (nn >> 8) * 128 + (nn & 127); }
    dst = (bf16_t*)(wl + W_INM); dstld = 1024;
  } else if (r < 1184) {
    r -= 1152; n0 = (r / 4) * 64; k0 = (r % 4) * 256; src = p.in_(I_WIN) + (size_t)l * 1024 * 2304; srcld = 2304; scol = 1024 + n0 + lane;
    dst = (bf16_t*)(wl + W_WV); dstld = 1024;
  } else {
    r -= 1184; n0 = (r / 2) * 64; k0 = (r % 2) * 256; src = p.in_(I_WOUT) + (size_t)l * 1024 * 1024; srcld = 1024; scol = n0 + lane;
    dst = (bf16_t*)(wl + W_WOUT); dstld = 1024;
  }
  LAS float* tile = (LAS float*)lds;
  const float* sp = src + (size_t)(k0 + wid) * srcld + scol;
  { float tt_[32];
#pragma unroll
    for (int i = 0; i < 32; ++i) tt_[i] = sp[(size_t)(8 * i) * srcld];
#pragma unroll
    for (int i = 0; i < 32; ++i) tile[(wid + 8 * i) * 65 + lane] = tt_[i]; }
  __syncthreads();
  { const int row = tid >> 3, ch = tid & 7;
#pragma unroll
    for (int c = 0; c < 4; ++c) { const LAS float* s = tile + (8 * (ch + 8 * c)) * 65 + row;
      u32x4 o; o.x = cvtpk(s[0], s[65]); o.y = cvtpk(s[130], s[195]); o.z = cvtpk(s[260], s[325]); o.w = cvtpk(s[390], s[455]);
      *(u32x4*)(dst + (size_t)(n0 + row) * dstld + k0 + 8 * (ch + 8 * c)) = o; } }
  __syncthreads();
}

__device__ __forceinline__ void p0_wfour(const DP& p, LAS unsigned char* lds, int it, int tid, int lane, int wid) {
  const int l = it >> 6, g = (it >> 4) & 3, k0 = (it & 15) * 64;
  LAS float* tile = (LAS float*)lds; LAS float* cs = tile + 64 * 65; LAS float* sn = cs + 64;
  const float* win = p.in_(I_WIN) + (size_t)l * 1024 * 2304;
#pragma unroll
  for (int i = 0; i < 8; ++i) { const int kk = wid + 8 * i; tile[kk * 65 + lane] = win[(size_t)(k0 + kk) * 2304 + 2048 + 64 * g + lane]; }
  if (tid < 64) { cs[tid] = __builtin_amdgcn_cosf((float)tid * (1.f / 64.f)); sn[tid] = __builtin_amdgcn_sinf((float)tid * (1.f / 64.f)); }
  __syncthreads();
  bf16_t* dst = (bf16_t*)(p.ws + WS_W + (size_t)l * WL + W_WFR);
  const int kk = lane;
  for (int i = 0; i < 16; ++i) {
    const int fidx = wid + 8 * i, comp = fidx >> 6, j = fidx & 63; float s = 0.f;
    for (int c = 0; c < 64; ++c) { const int mi = (j * c) & 63; const float tw = comp ? -sn[mi] : cs[mi]; s += tile[kk * 65 + c] * tw; }
    dst[(size_t)(g * 128 + fidx) * 1024 + k0 + kk] = (bf16_t)(cvtpk(s, 0.f) & 0xffffu);
  }
  __syncthreads();
}

__device__ __forceinline__ void p0_woutfold(const DP& p, LAS unsigned char* lds, int it, int tid, int lane, int wid) {
  const int l = it >> 6, which = (it >> 5) & 1, n0 = ((it >> 1) & 15) * 64, kh = it & 1;
  LAS float* wo = (LAS float*)lds;
  LAS float* w2s = wo + 256 * 64 + wid * 2048;
  const float* wout = p.in_(I_WOUT) + (size_t)l * 1024 * 1024 + (size_t)(512 + 256 * which) * 1024;
  { float wt_[32];
#pragma unroll
    for (int i = 0; i < 32; ++i) wt_[i] = wout[(size_t)(wid + 8 * i) * 1024 + n0 + lane];
#pragma unroll
    for (int i = 0; i < 32; ++i) wo[(wid + 8 * i) * 64 + lane] = wt_[i]; }
  __syncthreads();
  const float* W2 = (which ? p.in_(I_WF) : p.in_(I_WPW)) + (size_t)l * 256 * 256;
  bf16_t* dst = (bf16_t*)(p.ws + WS_W + (size_t)l * WL + W_WOUT);
  for (int i8 = 0; i8 < 2; ++i8) {
    const int kp0 = kh * 128 + wid * 16 + i8 * 8;
#pragma unroll
    for (int e = 0; e < 8; ++e) *(LAS f32x4*)(w2s + e * 256 + 4 * lane) = *(const f32x4*)(W2 + (size_t)(kp0 + e) * 256 + 4 * lane);
    asm volatile("s_waitcnt vmcnt(0) lgkmcnt(0)" ::: "memory");
    float a[8];
#pragma unroll
    for (int e = 0; e < 8; ++e) a[e] = 0.f;
    for (int j = 0; j < 256; j += 4) {
      const float w0 = wo[j * 64 + lane], w1 = wo[(j + 1) * 64 + lane], w2 = wo[(j + 2) * 64 + lane], w3 = wo[(j + 3) * 64 + lane];
#pragma unroll
      for (int e = 0; e < 8; ++e) { const f32x4 c = *(const LAS f32x4*)(w2s + e * 256 + j); a[e] += c[0] * w0 + c[1] * w1 + c[2] * w2 + c[3] * w3; }
    }
    u32x4 o; o.x = cvtpk(a[0], a[1]); o.y = cvtpk(a[2], a[3]); o.z = cvtpk(a[4], a[5]); o.w = cvtpk(a[6], a[7]);
    *(u32x4*)(dst + (size_t)(n0 + lane) * 1024 + 512 + 256 * which + kp0) = o;
    asm volatile("s_waitcnt lgkmcnt(0)" ::: "memory");
  }
  __syncthreads();
}

__device__ __forceinline__ void p0_biasy(const DP& p, int l, int tid) {
  const float* wout = p.in_(I_WOUT) + (size_t)l * 1024 * 1024; const float* bpw = p.in_(I_BPW) + l * 256; const float* bf = p.in_(I_BF) + l * 256;
  float* by = (float*)(p.ws + WS_BIASY) + l * 1024;
  for (int n = tid; n < 1024; n += 512) { float s = 0.f;
    for (int j = 0; j < 256; ++j) s += bpw[j] * wout[(size_t)(512 + j) * 1024 + n] + bf[j] * wout[(size_t)(768 + j) * 1024 + n];
    by[n] = s; }
}

__device__ __forceinline__ void p0_mod(const DP& p, LAS unsigned char* lds, int it, int tid, int lane, int wid) {
  const int l = it / 144, cb = it % 144;
  LAS float* s = (LAS float*)lds;
  LAS float* red = s + 5 * 1024;
  for (int i = tid; i < 5 * 1024; i += 512) { const int r = i >> 10, k = i & 1023; const float v = r < 4 ? p.in_(I_C)[r * 1024 + k] : p.in_(I_CCTX)[k]; s[i] = silu_f(v); }
  __syncthreads();
  const float* w = p.in_(I_WADA) + (size_t)l * 1024 * NMOD + cb * 64 + lane;
  float a0 = 0.f, a1 = 0.f, a2 = 0.f, a3 = 0.f, a4 = 0.f;
#pragma unroll 8
  for (int i = 0; i < 128; ++i) { const int k = wid + 8 * i; const float wv = w[(size_t)k * NMOD];
    a0 += s[k] * wv; a1 += s[1024 + k] * wv; a2 += s[2048 + k] * wv; a3 += s[3072 + k] * wv; a4 += s[4096 + k] * wv; }
  red[(wid * 5 + 0) * 64 + lane] = a0; red[(wid * 5 + 1) * 64 + lane] = a1; red[(wid * 5 + 2) * 64 + lane] = a2; red[(wid * 5 + 3) * 64 + lane] = a3; red[(wid * 5 + 4) * 64 + lane] = a4;
  __syncthreads();
  if (tid < 320) { const int r = tid >> 6, col = tid & 63; float v = p.in_(I_BADA)[(size_t)l * NMOD + cb * 64 + col];
#pragma unroll
    for (int w8 = 0; w8 < 8; ++w8) v += red[(w8 * 5 + r) * 64 + col];
    ((float*)(p.ws + WS_MOD))[((size_t)l * 5 + r) * NMOD + cb * 64 + col] = v; }
  __syncthreads();
}

__device__ __forceinline__ void p0_tables(const DP& p, int it, int tid) {
  if (it < 1024) {
    const int idx = it * 512 + tid, R = idx >> 6, C0 = (idx & 63) * 8;
    const int q = R >> 8, a = (R >> 6) & 3, k2 = R & 63, k = 4 * q + a + 128 * k2;
    const int ap = C0 >> 7, comp = (C0 >> 6) & 1, n20 = C0 & 63;
    float v[8];
#pragma unroll
    for (int e = 0; e < 8; ++e) { const int mi = ((n20 + e) * k) & 8191; const float fr = (float)mi * (1.f / 8192.f);
      const float t = comp ? __builtin_amdgcn_sinf(fr) : __builtin_amdgcn_cosf(fr); v[e] = (ap == a) ? t * 0.001381067932f : 0.f; }
    u32x4 o; o.x = cvtpk(v[0], v[1]); o.y = cvtpk(v[2], v[3]); o.z = cvtpk(v[4], v[5]); o.w = cvtpk(v[6], v[7]);
    *(u32x4*)((bf16_t*)(p.ws + WS_EBD) + (size_t)R * 512 + C0) = o;
  } else if (it < 1040) {
    const int idx = (it - 1024) * 512 + tid, row = idx >> 5, C0 = (idx & 31) * 8;
    const int compo = row >> 7, k1 = row & 127, comp = C0 >> 7, n10 = C0 & 127;
    float v[8];
#pragma unroll
    for (int e = 0; e < 8; ++e) { const int mi = (k1 * (n10 + e)) & 127; const float fr = (float)mi * (1.f / 128.f);
      const float cc = __builtin_amdgcn_cosf(fr), ss = __builtin_amdgcn_sinf(fr); v[e] = compo == 0 ? (comp == 0 ? cc : ss) : (comp == 0 ? -ss : cc); }
    u32x4 o; o.x = cvtpk(v[0], v[1]); o.y = cvtpk(v[2], v[3]); o.z = cvtpk(v[4], v[5]); o.w = cvtpk(v[6], v[7]);
    *(u32x4*)((bf16_t*)(p.ws + WS_DA) + (size_t)row * 256 + C0) = o;
  } else if (it < 1072) {
    const int idx = (it - 1040) * 512 + tid, k = idx >> 6, C0 = (idx & 63) * 8, comp = C0 >> 8, n0 = C0 & 255;
    float v[8];
#pragma unroll
    for (int e = 0; e < 8; ++e) { const int mi = (k * (n0 + e)) & 255; const float fr = (float)mi * (1.f / 256.f);
      v[e] = (comp ? __builtin_amdgcn_sinf(fr) : __builtin_amdgcn_cosf(fr)) * (1.f / 128.f); }
    u32x4 o; o.x = cvtpk(v[0], v[1]); o.y = cvtpk(v[2], v[3]); o.z = cvtpk(v[4], v[5]); o.w = cvtpk(v[6], v[7]);
    *(u32x4*)((bf16_t*)(p.ws + WS_E256) + (size_t)k * 512 + C0) = o;
  } else {
    f32x2* rope = (f32x2*)(p.ws + WS_ROPE);
    for (int i = tid; i < 129 * 16; i += 512) { const int pos = i >> 4, fi = i & 15;
      float cc = 1.f, ss = 0.f;
      if (pos < 128) { const float inv = __builtin_amdgcn_exp2f(-(float)fi * (13.287712379549449f / 16.f)); const float ang = (float)pos * inv;
        const double turns = (double)ang * 0.15915494309189535; const float fr = (float)(turns - (double)(long long)turns);
        cc = __builtin_amdgcn_cosf(fr); ss = __builtin_amdgcn_sinf(fr); }
      rope[i] = (f32x2){cc, ss}; }
  }
}

__device__ __forceinline__ void norm_row(const float* xr, float* xwb, const int nc_pend_ks, const float* nc_gate, const float nc_gmul, const float* nc_bias, const unsigned char* ws, int cidx, const f32x4 (&ca)[4], const f32x4 (&cb)[4], bf16_t* ho, bf16_t* hpo, int lane) {
  f32x4 v[4];
#pragma unroll
  for (int j = 0; j < 4; ++j) v[j] = __builtin_nontemporal_load((const f32x4*)(xr + 4 * lane + 256 * j));
  if (nc_pend_ks > 0) {
    f32x4 s4[4];
#pragma unroll
    for (int j = 0; j < 4; ++j) s4[j] = nc_bias ? *(const f32x4*)(nc_bias + 4 * lane + 256 * j) : (f32x4){0.f, 0.f, 0.f, 0.f};
    const float* pp = (const float*)(ws + WS_PART) + (size_t)cidx * DM + 4 * lane;
    for (int kc0 = 0; kc0 < nc_pend_ks; kc0 += 4) {
      f32x4 t4[4][4];
#pragma unroll
      for (int kk = 0; kk < 4; ++kk) { const int kc = (kc0 + kk < nc_pend_ks) ? kc0 + kk : kc0;
#pragma unroll
        for (int j = 0; j < 4; ++j) t4[kk][j] = *(const f32x4*)(pp + (size_t)kc * NCTX * DM + 256 * j); }
#pragma unroll
      for (int kk = 0; kk < 4; ++kk) { if (kc0 + kk < nc_pend_ks) {
#pragma unroll
        for (int j = 0; j < 4; ++j) s4[j] += t4[kk][j]; } }
    }
#pragma unroll
    for (int j = 0; j < 4; ++j) { v[j] += *(const f32x4*)(nc_gate + 4 * lane + 256 * j) * nc_gmul * s4[j]; *(f32x4*)(xwb + 4 * lane + 256 * j) = v[j]; }
  }
  float ss = 0.f;
#pragma unroll
  for (int j = 0; j < 4; ++j) ss += (v[j][0] * v[j][0] + v[j][1] * v[j][1]) + (v[j][2] * v[j][2] + v[j][3] * v[j][3]);
  const float rstd = 1.0f / sqrtf(wave_sum(ss, lane) * (1.f / DM) + EPS);
  u32x2 o[4];
#pragma unroll
  for (int j = 0; j < 4; ++j) { const f32x4 h = v[j] * rstd * ca[j] + cb[j]; o[j].x = cvtpk(h[0], h[1]); o[j].y = cvtpk(h[2], h[3]); }
#pragma unroll
  for (int j = 0; j < 4; ++j) *(u32x2*)(ho + 4 * lane + 256 * j) = o[j];
  if (hpo) {
#pragma unroll
    for (int j = 0; j < 4; ++j) *(u32x2*)(hpo + 4 * lane + 256 * j) = o[j]; }
}
__device__ __forceinline__ void norm_phase(const float* x_lat, const float* x_ctx, float* xc_wb, const float* g, const float* mod, int ish, bf16_t* hbf, bf16_t* hbfp, bool with_ctx,
                                           const int nc_pend_ks, const float* nc_gate, const float nc_gmul, const float* nc_bias, const unsigned char* ws, int gw0, int nwaves, int lane) {
  f32x4 ca[4], cb[4];
  for (int gw = gw0; gw < NLAT / 16; gw += nwaves) {
    const int r0 = gw * 16, mr = r0 >> 13; const float* sh = mod + (size_t)mr * NMOD + ish * DM; const float* sc = sh + DM;
#pragma unroll
    for (int j = 0; j < 4; ++j) { const int c = 4 * lane + 256 * j; const f32x4 gv = *(const f32x4*)(g + c), sv = *(const f32x4*)(sc + c); ca[j] = gv * (sv + 1.f); cb[j] = *(const f32x4*)(sh + c); }
    for (int r = r0; r < r0 + 16; ++r) {
      bf16_t* hp = nullptr;
      if (hbfp) { const int b = r >> 13, n = r & 8191, rho = (b << 13) + ((n & 63) << 7) + (n >> 6); hp = hbfp + (size_t)rho * DM; }
      norm_row(x_lat + (size_t)r * DM, nullptr, 0, nullptr, 0.f, nullptr, ws, 0, ca, cb, hbf + (size_t)r * DM, hp, lane);
    }
  }
  if (with_ctx) for (int gw = gw0; gw < NCTX; gw += nwaves) {
    const float* sh = mod + (size_t)4 * NMOD + ish * DM; const float* sc = sh + DM;
#pragma unroll
    for (int j = 0; j < 4; ++j) { const int c = 4 * lane + 256 * j; const f32x4 gv = *(const f32x4*)(g + c), sv = *(const f32x4*)(sc + c); ca[j] = gv * (sv + 1.f); cb[j] = *(const f32x4*)(sh + c); }
    norm_row(x_ctx + (size_t)gw * DM, xc_wb + (size_t)gw * DM, nc_pend_ks, nc_gate, nc_gmul, nc_bias, ws, gw, ca, cb, hbf + (size_t)(NLAT + gw) * DM, nullptr, lane);
  }
}

constexpr int AT_K = 9216, AT_V = 18432, AT_STAGE = 2 * AT_K + AT_V;
constexpr float AT_THR = 8.0f;
__device__ __forceinline__ void attn_unit(LAS unsigned char* lds, const unsigned char* ws, int b, int h, int q0, int kbeg, int nkt, int catrow0,
                                          float lam, float outscale, const float* gsub, int tid, int lane, int wid) {
  const bf16_t* Qs = (const bf16_t*)(ws + WS_REG + R_QS); const bf16_t* Ks = (const bf16_t*)(ws + WS_REG + R_KS); const bf16_t* Vt = (const bf16_t*)(ws + WS_REG + R_VT);
  const int isub = wid >> 2, qw = q0 + 32 * (wid & 3), l32 = lane & 31, hh = lane >> 5;
  const bool defer = isub == 1;
  bf16x8 qf[4];
  { const bf16_t* qp = Qs + ((size_t)(((b * 4 + h) * 2 + isub)) * NKV + qw + l32) * 64 + 8 * hh;
#pragma unroll
    for (int ks = 0; ks < 4; ++ks) qf[ks] = *(const bf16x8*)(qp + 16 * ks); }
  const int krow = tid >> 3, kch = tid & 7;
  const bf16_t* ksrc0 = Ks + ((size_t)(((b * 4 + h) * 2 + 0)) * NKV + kbeg + krow) * 64 + kch * 8;
  const bf16_t* ksrc1 = ksrc0 + (size_t)NKV * 64;
  const bf16_t* vsrc0 = Vt + ((size_t)((b * 4 + h) * 128 + krow)) * NKV + kbeg + kch * 8;
  const bf16_t* vsrc1 = vsrc0 + (size_t)64 * NKV;
  const int kdst = krow * 144 + kch * 16, vdst = 2 * AT_K + krow * 144 + kch * 16;
  u32x4 pk0, pk1, pv0, pv1;
  pk0 = *(const u32x4*)ksrc0; pk1 = *(const u32x4*)ksrc1; pv0 = *(const u32x4*)vsrc0; pv1 = *(const u32x4*)vsrc1;
#define AT_WRITE(soff) do { LAS unsigned char* sb_ = lds + (soff); \
    *(LAS u32x4*)(sb_ + kdst) = pk0; *(LAS u32x4*)(sb_ + AT_K + kdst) = pk1; \
    *(LAS u32x4*)(sb_ + vdst) = pv0; *(LAS u32x4*)(sb_ + vdst + 64 * 144) = pv1; } while (0)
#define AT_PV(soff) do { const LAS unsigned char* vb_ = lds + (soff) + 2 * AT_K + l32 * 144 + hh * 16; \
    _Pragma("unroll") for (int d = 0; d < 4; ++d) { _Pragma("unroll") for (int s4 = 0; s4 < 4; ++s4) { \
      const bf16x8 vv_ = *(const LAS bf16x8*)(vb_ + d * 32 * 144 + s4 * 32); \
      O[d] = __builtin_amdgcn_mfma_f32_32x32x16_bf16(vv_, pf[s4], O[d], 0, 0, 0); } } } while (0)
  AT_WRITE(0);
  __syncthreads();
  f32x16 O[4];
#pragma unroll
  for (int d = 0; d < 4; ++d)
#pragma unroll
    for (int r = 0; r < 16; ++r) O[d][r] = 0.f;
  f32x16 negm;
#pragma unroll
  for (int r = 0; r < 16; ++r) negm[r] = 0.f;
  float lrun = 0.f;
  bf16x8 pf[4];
#pragma unroll
  for (int s4 = 0; s4 < 4; ++s4) pf[s4] = (bf16x8){0, 0, 0, 0, 0, 0, 0, 0};
  int s_prev = 2 * AT_STAGE, s_cur = 0, s_nxt = AT_STAGE;
  for (int t = 0; t <= nkt; ++t) {
    const bool more = (t + 1 < nkt), have = (t < nkt);
    if (more) { const size_t ko = (size_t)(t + 1) * 64 * 64, vo = (size_t)(t + 1) * 64;
      pk0 = *(const u32x4*)(ksrc0 + ko); pk1 = *(const u32x4*)(ksrc1 + ko); pv0 = *(const u32x4*)(vsrc0 + vo); pv1 = *(const u32x4*)(vsrc1 + vo); }
    if (defer && t > 0) AT_PV(s_prev);
    if (have) {
      const LAS unsigned char* kb = lds + s_cur + isub * AT_K + l32 * 144 + hh * 16;
      f32x16 S0 = negm, S1 = negm;
#pragma unroll
      for (int ks = 0; ks < 4; ++ks) {
        const bf16x8 k0 = *(const LAS bf16x8*)(kb + ks * 32), k1 = *(const LAS bf16x8*)(kb + 32 * 144 + ks * 32);
        S0 = __builtin_amdgcn_mfma_f32_32x32x16_bf16(k0, qf[ks], S0, 0, 0, 0);
        S1 = __builtin_amdgcn_mfma_f32_32x32x16_bf16(k1, qf[ks], S1, 0, 0, 0);
      }
      float mx = fmaxf(fmaxf(S0[0], S0[1]), S1[0]);
#pragma unroll
      for (int r = 2; r < 16; r += 2) mx = fmaxf(fmaxf(mx, S0[r]), S0[r + 1]);
#pragma unroll
      for (int r = 1; r < 15; r += 2) mx = fmaxf(fmaxf(mx, S1[r]), S1[r + 1]);
      mx = fmaxf(mx, S1[15]);
      mx = fmaxf(mx, shx(mx, 32, lane));
      if (t == 0 || __any(mx > AT_THR)) {
        const float dl = (t == 0) ? mx : fmaxf(mx, 0.f);
        const float f = (t == 0) ? 1.f : __builtin_amdgcn_exp2f(-dl);
        lrun *= f;
#pragma unroll
        for (int d = 0; d < 4; ++d)
#pragma unroll
          for (int r = 0; r < 16; ++r) O[d][r] *= f;
#pragma unroll
        for (int r = 0; r < 16; ++r) { S0[r] -= dl; S1[r] -= dl; negm[r] -= dl; }
      }
      float ps = 0.f;
#pragma unroll
      for (int r = 0; r < 16; ++r) { S0[r] = __builtin_amdgcn_exp2f(S0[r]); S1[r] = __builtin_amdgcn_exp2f(S1[r]); ps += S0[r] + S1[r]; }
      lrun += ps;
      { u32x4 w;
        w.x = cvtpk(S0[0], S0[1]); w.y = cvtpk(S0[2], S0[3]); w.z = cvtpk(S0[4], S0[5]); w.w = cvtpk(S0[6], S0[7]); pf[0] = __builtin_bit_cast(bf16x8, w);
        w.x = cvtpk(S0[8], S0[9]); w.y = cvtpk(S0[10], S0[11]); w.z = cvtpk(S0[12], S0[13]); w.w = cvtpk(S0[14], S0[15]); pf[1] = __builtin_bit_cast(bf16x8, w);
        w.x = cvtpk(S1[0], S1[1]); w.y = cvtpk(S1[2], S1[3]); w.z = cvtpk(S1[4], S1[5]); w.w = cvtpk(S1[6], S1[7]); pf[2] = __builtin_bit_cast(bf16x8, w);
        w.x = cvtpk(S1[8], S1[9]); w.y = cvtpk(S1[10], S1[11]); w.z = cvtpk(S1[12], S1[13]); w.w = cvtpk(S1[14], S1[15]); pf[3] = __builtin_bit_cast(bf16x8, w); }
      if (!defer) AT_PV(s_cur);
    }
    if (more) AT_WRITE(s_nxt);
    if (have) __syncthreads();
    { const int tmp = s_prev; s_prev = s_cur; s_cur = s_nxt; s_nxt = tmp; }
  }
  __syncthreads();
#undef AT_WRITE
#undef AT_PV
  const float ltot = lrun + shx(lrun, 32, lane);
  const float rl = 1.f / ltot;
  LAS float* X = (LAS float*)lds;
  const int q = 32 * (wid & 3) + l32;
  if (isub == 1) {
#pragma unroll
    for (int d = 0; d < 4; ++d)
#pragma unroll
      for (int g4 = 0; g4 < 4; ++g4) { const int dv = 32 * d + 8 * g4 + 4 * hh;
        *(LAS f32x4*)(X + q * 132 + dv) = (f32x4){O[d][4 * g4] * rl, O[d][4 * g4 + 1] * rl, O[d][4 * g4 + 2] * rl, O[d][4 * g4 + 3] * rl}; }
  }
  __syncthreads();
  if (isub == 0) {
    float ssq = 0.f;
#pragma unroll
    for (int d = 0; d < 4; ++d)
#pragma unroll
      for (int g4 = 0; g4 < 4; ++g4) { const int dv = 32 * d + 8 * g4 + 4 * hh; const f32x4 o1 = *(const LAS f32x4*)(X + q * 132 + dv);
#pragma unroll
        for (int e = 0; e < 4; ++e) { const float v = O[d][4 * g4 + e] * rl - lam * o1[e]; O[d][4 * g4 + e] = v; ssq += v * v; } }
    ssq += shx(ssq, 32, lane);
    const float rn = outscale / sqrtf(ssq * (1.f / 128.f) + EPS);
    bf16_t* crow = (bf16_t*)(ws + WS_REG + R_CAT) + (size_t)(catrow0 + q) * DM + h * 128;
#pragma unroll
    for (int d = 0; d < 4; ++d)
#pragma unroll
      for (int g4 = 0; g4 < 4; ++g4) { const int dv = 32 * d + 8 * g4 + 4 * hh; const f32x4 gv = *(const f32x4*)(gsub + dv);
        u32x2 o; o.x = cvtpk(O[d][4 * g4] * rn * gv[0], O[d][4 * g4 + 1] * rn * gv[1]); o.y = cvtpk(O[d][4 * g4 + 2] * rn * gv[2], O[d][4 * g4 + 3] * rn * gv[3]);
        *(u32x2*)(crow + dv) = o; }
  }
  __syncthreads();
}

__device__ __forceinline__ void conv_unit(LAS unsigned char* lds, const DP& p, int l, int row0, int seq_lo, int seq_hi, int tid, int lane, int wid) {
  LAS unsigned char* yl = lds; LAS float* wl = (LAS float*)(lds + 48128);
  const bf16_t* yg = (const bf16_t*)(p.ws + WS_REG + R_YGLU);
  const float* wdw = p.in_(I_WDW) + (size_t)l * 31 * 256;
  {
    u32x4 yv_[6]; f32x4 wv_[4];
#pragma unroll
    for (int k = 0; k < 6; ++k) { const int i = tid + 512 * k, rr = i >> 5, ch = i & 31, r = row0 - 15 + rr;
      yv_[k] = (u32x4){0u, 0u, 0u, 0u}; if (i < 94 * 32 && r >= seq_lo && r < seq_hi) yv_[k] = *(const u32x4*)(yg + (size_t)r * 256 + ch * 8); }
#pragma unroll
    for (int k = 0; k < 4; ++k) { const int i = tid + 512 * k; wv_[k] = (f32x4){0.f, 0.f, 0.f, 0.f}; if (i < 31 * 64) wv_[k] = *(const f32x4*)(wdw + i * 4); }
#pragma unroll
    for (int k = 0; k < 6; ++k) { const int i = tid + 512 * k, rr = i >> 5, ch = i & 31; if (i < 94 * 32) *(LAS u32x4*)(yl + rr * 512 + ch * 16) = yv_[k]; }
#pragma unroll
    for (int k = 0; k < 4; ++k) { const int i = tid + 512 * k; if (i < 31 * 64) *(LAS f32x4*)(wl + i * 4) = wv_[k]; }
  }
  __syncthreads();
  f32x4 acc[8];
  { const f32x4 bd = *(const f32x4*)(p.in_(I_BDW) + l * 256 + 4 * lane);
#pragma unroll
    for (int i = 0; i < 8; ++i) acc[i] = bd; }
#pragma unroll 1
  for (int j = 0; j < 31; ++j) {
    const f32x4 wv = *(const LAS f32x4*)(wl + j * 256 + 4 * lane);
    const LAS unsigned char* yp = yl + (8 * wid + j) * 512 + lane * 8;
#pragma unroll
    for (int i = 0; i < 8; ++i) {
      const u32x2 raw = *(const LAS u32x2*)(yp + i * 512);
      const f32x4 yv = {bf2f(raw.x & 0xffffu), bf2f(raw.x >> 16), bf2f(raw.y & 0xffffu), bf2f(raw.y >> 16)};
      acc[i] += yv * wv;
    }
  }
  const f32x4 gl = *(const f32x4*)(p.in_(I_GCLN) + l * 256 + 4 * lane), bl = *(const f32x4*)(p.in_(I_BCLN) + l * 256 + 4 * lane);
  bf16_t* cat = (bf16_t*)(p.ws + WS_REG + R_CAT);
#pragma unroll
  for (int i = 0; i < 8; ++i) {
    const f32x4 v = acc[i];
    const float mu = wave_sum((v[0] + v[1]) + (v[2] + v[3]), lane) * (1.f / 256.f);
    const f32x4 d = v - mu;
    const float var = wave_sum((d[0] * d[0] + d[1] * d[1]) + (d[2] * d[2] + d[3] * d[3]), lane) * (1.f / 256.f);
    const float rs = 1.0f / sqrtf(var + EPS);
    const f32x4 y = d * rs * gl + bl;
    u32x2 o; o.x = cvtpk(silu_f(y[0]), silu_f(y[1])); o.y = cvtpk(silu_f(y[2]), silu_f(y[3]));
    *(u32x2*)(cat + (size_t)(row0 + 8 * wid + i) * DM + 512 + 4 * lane) = o;
  }
  __syncthreads();
}


#define XB_TMO      128
#define XB_XCNT(j)  (256  + 64 * (j))
#define XB_XSUB(j)  (1280 + 64 * (j))
#define XB_XGEN(j)  (2304 + 64 * (j))
#define XB_TOP      3328
#define XB_TOPGEN   3392
#define XCD_BAR_WORDS 3456
#define XB_SPIN_CAP (1u << 22)
__device__ __forceinline__ unsigned xb_ld(unsigned* p)              { return __hip_atomic_load(p, __ATOMIC_RELAXED, __HIP_MEMORY_SCOPE_AGENT); }
__device__ __forceinline__ unsigned xb_add(unsigned* p, unsigned v) { return __hip_atomic_fetch_add(p, v, __ATOMIC_RELAXED, __HIP_MEMORY_SCOPE_AGENT); }
__device__ __forceinline__ unsigned xb_xcc_id() { return (unsigned)__builtin_amdgcn_s_getreg((3 << 11) | 20) & 0xFu; }
#define XB_SPIN(cond, bar) do { unsigned _sp = 0; while (cond) { __builtin_amdgcn_s_sleep(1); \
    if ((++_sp & 255u) == 0u) { if (xb_ld(&(bar)[XB_TMO])) break; if (_sp > XB_SPIN_CAP) { atomicAdd(&(bar)[XB_TMO], 1u); break; } } } } while (0)
struct XcdBarrier { unsigned* bar; unsigned x; volatile LAS unsigned* st; };
__device__ __forceinline__ void xcd_barrier_complete(unsigned* bar, unsigned x, unsigned& nloc, unsigned& nx, unsigned& even) {
  const unsigned G = gridDim.x * gridDim.y * gridDim.z;
  unsigned sum, cnt, mine, sp = 0u;
  for (;;) {
    sum = 0u; cnt = 0u; mine = 0u;
#pragma unroll
    for (unsigned j = 0; j < 16; ++j) { const unsigned c = xb_ld(&bar[XB_XCNT(j)]); sum += c; cnt += (c > 0u) ? 1u : 0u; mine = (j == x) ? c : mine; }
    if (sum == G) break;
    __builtin_amdgcn_s_sleep(1);
    if ((++sp & 255u) == 0u) { if (xb_ld(&bar[XB_TMO])) break; if (sp > XB_SPIN_CAP) { atomicAdd(&bar[XB_TMO], 1u); break; } }
  }
  nloc = mine > 0u ? mine : 1u; nx = cnt > 0u ? cnt : 1u;
  unsigned ev = (sum == G && cnt == 8u && (G & 7u) == 0u) ? 1u : 0u;
#pragma unroll
  for (unsigned j = 0; j < 16; ++j) { const unsigned c = xb_ld(&bar[XB_XCNT(j)]); if (c != 0u && (c != (G >> 3) || j >= 8u)) ev = 0u; }
  even = ev;
}
__device__ __forceinline__ void xcd_barrier(const XcdBarrier& b, int tid) {
  asm volatile("s_waitcnt vmcnt(0)" ::: "memory");
  __syncthreads();
  if (tid == 0) {
    unsigned* bar = b.bar;
    __builtin_amdgcn_s_waitcnt(0);
    unsigned nloc = b.st[0], nx = b.st[1];
    if (nloc == 0u) { unsigned even_ = 0u; xcd_barrier_complete(bar, b.x, nloc, nx, even_); b.st[0] = nloc; b.st[1] = nx; b.st[2] = even_; }
    const unsigned old = xb_add(&bar[XB_XSUB(b.x)], 1u);
    const unsigned gen = old / nloc;
    if (old + 1u == (gen + 1u) * nloc) {
      __builtin_amdgcn_fence(__ATOMIC_RELEASE, "agent");
      asm volatile("s_waitcnt vmcnt(0)" ::: "memory");
      const unsigned og = xb_add(&bar[XB_TOP], 1u);
      const unsigned tg = og / nx;
      if (og + 1u == (tg + 1u) * nx) xb_add(&bar[XB_TOPGEN], 1u);
      else XB_SPIN(xb_ld(&bar[XB_TOPGEN]) == tg, bar);
      __builtin_amdgcn_fence(__ATOMIC_ACQUIRE, "agent");
      xb_add(&bar[XB_XGEN(b.x)], 1u);
      asm volatile("s_waitcnt vmcnt(0)" ::: "memory");
    } else {
      XB_SPIN(xb_ld(&bar[XB_XGEN(b.x)]) == gen, bar);
      __builtin_amdgcn_fence(__ATOMIC_ACQUIRE, "agent");
      asm volatile("s_waitcnt vmcnt(0)" ::: "memory");
    }
  }
  __syncthreads();
}

__global__ void __launch_bounds__(512, 2) mega_fwd(Params kp) {
  extern __shared__ __attribute__((aligned(16))) unsigned char lds_raw[];
  LAS unsigned char* lds = (LAS unsigned char*)lds_raw;
  cg::grid_group grid = cg::this_grid();
  const int wid0 = __builtin_amdgcn_readfirstlane((int)threadIdx.x >> 6);
  int wid = wid0, lane = (int)__builtin_amdgcn_mbcnt_hi(~0u, __builtin_amdgcn_mbcnt_lo(~0u, 0u)), tid = wid * 64 + lane;
  const int G = gridDim.x, cb = blockIdx.x;
  int gw = cb * 8 + wid;
  unsigned char* ws = kp.ws;
  float* xlat = kp.out;
  DP p; p.tab = (const float* LAS*)(lds + PP_OFF); p.ws = ws;
  if (tid == 0) {
#pragma unroll
    for (int i = 0; i < 31; ++i) ((const float* LAS*)(lds + PP_OFF))[i] = kp.in[i];
    ((volatile LAS unsigned*)(lds + XB_OFF))[0] = 0u; ((volatile LAS unsigned*)(lds + XB_OFF))[1] = 0u; ((volatile LAS unsigned*)(lds + XB_OFF))[2] = 0u; ((volatile LAS unsigned*)(lds + XB_OFF))[3] = 0u;
  }
  if (cb == 0) { for (int i = tid; i < XCD_BAR_WORDS; i += 512) __hip_atomic_store((unsigned*)(ws + WS_BAR) + i, 0u, __ATOMIC_RELAXED, __HIP_MEMORY_SCOPE_AGENT); }
  __syncthreads(); float* xctx = (float*)(ws + WS_XC);
  bf16_t* hbf = (bf16_t*)(ws + WS_HBF);

  {
    const bool bgw = (G == 256);
    constexpr int N_MOD = 288, N_WF = 128, N_BY = 2, N_TB = 1073;
    const int N_WO = bgw ? 0 : 128, N_TR = bgw ? 1216 : 2 * 1216;
    const int T1 = N_WO, T2 = T1 + N_MOD, T3 = T2 + N_WF, T4 = T3 + N_BY, T5 = T4 + N_TR, T6 = T5 + N_TB;
    for (int it = cb; it < T6; it += G) {
      { unsigned z_ = 0u; asm volatile("" : "+s"(z_)); int t_ = (int)__builtin_amdgcn_mbcnt_hi(~0u, __builtin_amdgcn_mbcnt_lo(~0u, z_)); asm volatile("" : "+v"(t_)); lane = t_; wid = wid0; asm volatile("" : "+s"(wid)); tid = wid * 64 + lane; }
      if (it < T1) p0_woutfold(p, lds, it, tid, lane, wid);
      else if (it < T2) p0_mod(p, lds, it - T1, tid, lane, wid);
      else if (it < T3) p0_wfour(p, lds, it - T2, tid, lane, wid);
      else if (it < T4) p0_biasy(p, it - T3, tid);
      else if (it < T5) p0_transpose(p, lds, it - T4, tid, lane, wid);
      else p0_tables(p, it - T5, tid);
    }
  }
  grid.sync();
  XcdBarrier xbar; xbar.bar = (unsigned*)(kp.ws + WS_BAR); xbar.x = xb_xcc_id(); xbar.st = (volatile LAS unsigned*)(lds + XB_OFF);
  if (threadIdx.x == 0) xbar.st[3] = xb_add(&xbar.bar[XB_XCNT(xbar.x)], 1u);

#define RELAUNDER() do { unsigned z_ = 0u; asm volatile("" : "+s"(z_)); int t_ = (int)__builtin_amdgcn_mbcnt_hi(~0u, __builtin_amdgcn_mbcnt_lo(~0u, z_)); asm volatile("" : "+v"(t_)); \
    lane = t_; wid = wid0; asm volatile("" : "+s"(wid)); tid = wid * 64 + lane; gw = cb * 8 + wid; } while (0)
  for (int l_outer = 0; l_outer < 2; ++l_outer) {
    for (int sp = 0; sp < 12; ++sp) {
      int l = l_outer; asm volatile("" : "+s"(l));
      const bool last_layer = (l == 1);
      RELAUNDER();
      { unsigned long long w_ = (unsigned long long)kp.ws; asm volatile("" : "+s"(w_)); ws = (unsigned char*)w_; p.ws = ws; }
      const int cbv = (__builtin_amdgcn_readfirstlane((int)xbar.st[2]) != 0) ? __builtin_amdgcn_readfirstlane((int)xbar.st[3]) * 8 + (int)xbar.x : cb;
      const unsigned char* wl = ws + WS_W + (size_t)l * WL;
      const float* mod = (const float*)(ws + WS_MOD) + (size_t)l * 5 * NMOD;
      float* xctx = (float*)(ws + WS_XC); bf16_t* hbf = (bf16_t*)(ws + WS_HBF);
      bool do_gemm = false, do_sync = true;
      int K = 1024, lda = 1024, ldb = 1024;
      const pg8::Job JZ = {nullptr, nullptr, 0, 1, 0, 0, 16, 1, 0, 0};
      pg8::Job J0 = JZ, J1 = JZ, J2 = JZ, J3 = JZ; int e0 = 0, e1 = -1, e2 = -1, e3 = -1;
      const float* xin_lat = xlat; const float* xin_ctx = xctx; const float* biasy = nullptr; int gate_idx = 2; float gate_mul = 0.5f;
      const int nrt_all = 132;
      const int nrt_late = last_layer ? 128 : 132;
      if (sp == 0 || sp == 3 || sp == 9) {
        if (sp == 3 && LEVEL < 2) { do_sync = false; }
        else {
          const bool first = (l == 0 && sp == 0);
          const float* xl = first ? p.in_(I_X) : xlat;
          const float* g = p.in_(sp == 0 ? I_GF1 : (sp == 3 ? I_GMIX : I_GF2)) + l * DM;
          const int ish = sp == 0 ? 0 : (sp == 3 ? 3 : 6);
          const bool with_ctx = !(sp == 9 && last_layer);
          bf16_t* hp = (sp == 3) ? (bf16_t*)(ws + WS_REG + R_HBFP) : nullptr;
          int nc_ks = 0; const float* nc_gate = nullptr; float nc_gmul = 0.f; const float* nc_bias = nullptr; const float* xc_src = xctx;
          const float* modp = (const float*)(ws + WS_MOD);
          if (sp == 3) { nc_ks = 11; nc_gate = mod + (size_t)4 * NMOD + 2 * DM; nc_gmul = 0.5f; if (l == 0) xc_src = p.in_(I_CTX); }
          else if (sp == 9 && !last_layer) { nc_ks = 4; nc_gate = mod + (size_t)4 * NMOD + 5 * DM; nc_gmul = 1.f; nc_bias = (const float*)(ws + WS_BIASY) + l * 1024; }
          else if (sp == 0 && l == 1) { nc_ks = 11; nc_gate = modp + (size_t)4 * NMOD + 8 * DM; nc_gmul = 0.5f; }
          else if (sp == 0) { xc_src = p.in_(I_CTX); }
          norm_phase(xl, xc_src, xctx, g, mod, ish, hbf, hp, with_ctx, nc_ks, nc_gate, nc_gmul, nc_bias, ws, gw, G * 8, lane);
        }
      } else if (sp == 1 || sp == 10) {
        do_gemm = true; const int nrt = sp == 1 ? nrt_all : nrt_late;
        J0 = (pg8::Job){(const char*)hbf, (const char*)(wl + (sp == 1 ? W_FF1A : W_FF2A)), nrt, 22, K_GATEUP, 0, 16, 1, 0, 0}; e0 = nrt * 22;
      } else if (sp == 2 || sp == 11) {
        do_gemm = true; K = DFF; lda = DFF; ldb = DFF; const int nrt = sp == 2 ? nrt_all : nrt_late;
        J0 = (pg8::Job){(const char*)(ws + WS_REG + R_ACT), (const char*)(wl + (sp == 2 ? W_DN1 : W_DN2)), 128, 4, K_RES, 0, 44, 1, 0, 0}; e0 = 512;
        if (nrt > 128) { J1 = (pg8::Job){(const char*)(ws + WS_REG + R_ACT) + (size_t)NLAT * DFF * 2, (const char*)(wl + (sp == 2 ? W_DN1 : W_DN2)), 4, 4, K_RESP, 0, 4, 11, 128, 0}; e1 = e0 + 176; }
        gate_idx = sp == 2 ? 2 : 8; gate_mul = 0.5f;
        if (l == 0 && sp == 2) { xin_lat = p.in_(I_X); xin_ctx = p.in_(I_CTX); }
      } else if (LEVEL < 2) {
        do_sync = false;
      } else if (sp == 4) {
        do_gemm = true;
        J0 = (pg8::Job){(const char*)hbf, (const char*)(wl + W_INM), nrt_all, 6, K_INM, 0, 16, 1, 0, 0}; e0 = nrt_all * 6;
        J1 = (pg8::Job){(const char*)(wl + W_WV), (const char*)hbf, 2, nrt_all, K_VT, 0, 16, 1, 0, 0}; e1 = e0 + 2 * nrt_all;
        J2 = (pg8::Job){(const char*)(wl + W_WFR), (const char*)(ws + WS_REG + R_HBFP), 2, 128, K_FG, 0, 16, 1, 0, 0}; e2 = e1 + 256;
        J3 = (pg8::Job){(const char*)(wl + W_WFR), (const char*)(hbf + (size_t)NLAT * DM), 2, 4, K_FGC, 0, 16, 1, 0, 0}; e3 = e2 + (last_layer ? 0 : 8);
      } else if (sp == 5) {
        float lam;
        { const float a = wave_sum(p.in_(I_LQ1)[l * 64 + lane] * p.in_(I_LK1)[l * 64 + lane], lane), b2 = wave_sum(p.in_(I_LQ2)[l * 64 + lane] * p.in_(I_LK2)[l * 64 + lane], lane);
          const float lam_init = l == 0 ? 0.2f : 0.35550906f; lam = __expf(a) - __expf(b2) + lam_init; }
        const float oscale = l == 0 ? 0.8f : (1.f - 0.35550906f);
        const float* gsub = p.in_(I_GSUB) + l * 128;
        const int xcd = cbv & 7, cl = cbv >> 3;
        if (G == 256) {
          for (int i = 0; i < 4; ++i) { const int idx = i * 32 + cl, bh = 2 * xcd + (idx >> 6), qb = idx & 63;
            attn_unit(lds, ws, bh >> 2, bh & 3, qb * 128, 0, 132, (bh >> 2) * SEQ + qb * 128, lam, oscale, gsub, tid, lane, wid); }
        } else {
          for (int u = cbv; u < 1024; u += G) { const int bh = u >> 6, qb = u & 63;
            attn_unit(lds, ws, bh >> 2, bh & 3, qb * 128, 0, 132, (bh >> 2) * SEQ + qb * 128, lam, oscale, gsub, tid, lane, wid); }
        }
        if (!last_layer) for (int u = cbv; u < 32; u += G) { const int bh = u >> 1, qb = u & 1;
          attn_unit(lds, ws, bh >> 2, bh & 3, SEQ + qb * 128, SEQ, 4, NLAT + (bh >> 2) * CTXL + qb * 128, lam, oscale, gsub, tid, lane, wid); }
        RELAUNDER();
        if (LEVEL >= 3) { const int ncu = last_layer ? 512 : 528;
          for (int u = cbv; u < ncu; u += G) { const int row0 = u * 64; int lo, hi;
            if (row0 < NLAT) { lo = row0 & ~8191; hi = lo + SEQ; } else { lo = NLAT + ((row0 - NLAT) & ~255); hi = lo + CTXL; }
            conv_unit(lds, p, l, row0, lo, hi, tid, lane, wid); } }
        RELAUNDER();
        if (LEVEL >= 4) { do_gemm = true; K = 256; lda = 256; ldb = 256;
          J0 = (pg8::Job){(const char*)(ws + WS_DA), (const char*)(ws + WS_REG + R_GT), 1, 256, K_STA, 0, 4, 1, 0, 0}; e0 = 256; }
      } else if (sp == 6) {
        if (LEVEL >= 4) { do_gemm = true; K = 512; lda = 512; ldb = 16384; do_sync = last_layer;
          J0 = (pg8::Job){(const char*)(ws + WS_EBD), (const char*)(ws + WS_REG + R_T), 32, 4, K_STB, 1024, 8, 1, 0, 0}; e0 = 128; }
        else do_sync = false;
      } else if (sp == 7) {
        if (LEVEL >= 4 && !last_layer) { do_gemm = true; K = 512; lda = 512; ldb = 512;
          J0 = (pg8::Job){(const char*)(ws + WS_E256), (const char*)(ws + WS_REG + R_GTC), 1, 4, K_FC, 0, 8, 1, 0, 0}; e0 = 4; }
        else do_sync = false;
      } else if (sp == 8) {
        do_gemm = true;
        J0 = (pg8::Job){(const char*)(ws + WS_REG + R_CAT), (const char*)(wl + W_WOUT), 128, 4, K_RES, 0, 16, 1, 0, 0}; e0 = 512;
        if (nrt_late > 128) { J1 = (pg8::Job){(const char*)(ws + WS_REG + R_CAT) + (size_t)NLAT * DM * 2, (const char*)(wl + W_WOUT), 4, 4, K_RESP, 0, 4, 4, 128, 0}; e1 = e0 + 64; }
        gate_idx = 5; gate_mul = 1.f; biasy = (const float*)(ws + WS_BIASY) + l * 1024;
      }
      if (do_gemm) {
        LAS pg8::PhaseDesc* pd = (LAS pg8::PhaseDesc*)(lds + PD_OFF);
        if (e1 < 0) e1 = e0; if (e2 < 0) e2 = e1; if (e3 < 0) e3 = e2;
        __syncthreads();
        if (tid == 0) {
#define PUTJ(i, J) do { pd->j[i].A = J.A; pd->j[i].B = J.B; pd->j[i].nM = J.nM; pd->j[i].nN = J.nN; pd->j[i].kind = J.kind; pd->j[i].kshift = J.kshift; pd->j[i].nt = J.nt; pd->j[i].ksplit = J.ksplit; pd->j[i].pmoff = J.pmoff; } while (0)
          PUTJ(0, J0); PUTJ(1, J1); PUTJ(2, J2); PUTJ(3, J3);
#undef PUTJ
          pd->e[0] = e0; pd->e[1] = e1; pd->e[2] = e2; pd->e[3] = e3;
          pd->xin_lat = xin_lat; pd->xin_ctx = xin_ctx; pd->xout_lat = xlat; pd->xout_ctx = xctx; pd->mod = mod; pd->biasy = biasy; pd->gate_idx = gate_idx; pd->gate_mul = gate_mul; }
        __syncthreads();
        pg8::Sched S; S.pd = pd; S.G = G; S.c = cbv; S.tsA = (size_t)256 * lda * 2; S.tsB = (size_t)256 * ldb * 2;
        Epi E; E.ws = ws; E.pd = pd;
        pg8::gemm_phase<Epi>(lds, tid, lda, ldb, S, E);
        if (G == 256 && l == 0 && (sp == 1 || sp == 4 || sp == 10)) {
          const int first_idle = (sp == 4) ? 40 : 88;
          const int nfold = (sp == 10) ? 0 : 64;
          const int tbase = (sp == 1) ? 0 : (sp == 4 ? 312 : 768);
          const int ci = cbv - first_idle;
          if (ci >= 0) {
            for (int j = 0; j < 3; ++j) {
              RELAUNDER();
              if (ci < nfold) { if (j == 0) p0_woutfold(p, lds, (sp == 1 ? 0 : 64) + ci, tid, lane, wid); }
              else { const int idx = tbase + (ci - nfold) * 3 + j; if (idx < 1216) p0_transpose(p, lds, 1216 + idx, tid, lane, wid); }
            }
          }
        }
      }
      if (do_sync) xcd_barrier(xbar, tid);
    }
  }
  {
    const float* g = p.in_(I_GFIN);
    f32x4 gv[4];
#pragma unroll
    for (int j = 0; j < 4; ++j) gv[j] = *(const f32x4*)(g + 4 * lane + 256 * j);
    for (int r = gw; r < NLAT; r += G * 8) {
      float* xr = xlat + (size_t)r * DM; f32x4 v[4]; float ss = 0.f;
#pragma unroll
      for (int j = 0; j < 4; ++j) { v[j] = __builtin_nontemporal_load((const f32x4*)(xr + 4 * lane + 256 * j)); ss += (v[j][0] * v[j][0] + v[j][1] * v[j][1]) + (v[j][2] * v[j][2] + v[j][3] * v[j][3]); }
      const float rstd = 1.0f / sqrtf(wave_sum(ss, lane) * (1.f / DM) + EPS);
#pragma unroll
      for (int j = 0; j < 4; ++j) *(f32x4*)(xr + 4 * lane + 256 * j) = v[j] * rstd * gv[j];
    }
  }
}

extern "C" void kernel_launch(void* const* d_in, const int* in_sizes, int n_in, void* d_out, int out_size, void* d_ws, size_t ws_size, hipStream_t stream) {
  static int grid = 0;
  if (grid == 0) {
    if (n_in != 31 || out_size != NLAT * DM || ws_size < WS_END) { fprintf(stderr, "kernel_launch: unexpected shapes (n_in %d out %d ws %zu need %zu)\n", n_in, out_size, ws_size, (size_t)WS_END); grid = -1; return; }
    int dev = 0, cus = 0, per_cu = 0;
    hipGetDevice(&dev); hipDeviceGetAttribute(&cus, hipDeviceAttributeMultiprocessorCount, dev);
    hipFuncSetAttribute((const void*)mega_fwd, hipFuncAttributeMaxDynamicSharedMemorySize, LDS_BYTES);
    hipOccupancyMaxActiveBlocksPerMultiprocessor(&per_cu, (const void*)mega_fwd, 512, LDS_BYTES);
    if (per_cu < 1) { fprintf(stderr, "kernel_launch: occupancy query says %d blocks/CU\n", per_cu); per_cu = 1; }
    (void)hipGetLastError();
    grid = cus * 1;
  }
  if (grid < 0) return;
  Params p{};
  for (int i = 0; i < 31; ++i) p.in[i] = (const float*)d_in[i];
  p.out = (float*)d_out; p.ws = (unsigned char*)d_ws;
  void* args[] = {&p};
  hipError_t e = hipLaunchCooperativeKernel((const void*)mega_fwd, dim3(grid), dim3(512), args, LDS_BYTES, stream);
  if (e != hipSuccess) fprintf(stderr, "cooperative launch failed: %s (grid %d)\n", hipGetErrorString(e), grid);
}
```
